# Optimizing an MI355X kernel written in HIP

```python
import jax, jax.numpy as jnp
from jax import lax
import numpy as np

D_MODEL = 1024
BATCH = 8
SEQ = 8192
DEPTH = 2

D_MIX = D_MODEL
D_RNN = D_MIX // 2
RNN_HEADS = 8
RNN_HEAD_DIM = D_RNN // RNN_HEADS
D_POOL = D_MIX // 4
POOL_WINDOWS = (2, 4, 8, 16)
POOL_GROUPS = len(POOL_WINDOWS)
POOL_GROUP_DIM = D_POOL // POOL_GROUPS
D_SGU = D_MIX // 4
SGU_HEADS = 4
SGU_HEAD_DIM = D_SGU // SGU_HEADS
CHUNK = 128
CONV_WIDTH = 4
LRU_C = 8.0
D_IN = 2 * D_RNN + D_POOL + 2 * D_SGU
D_FF = 64 * ((8 * D_MODEL // 3 + 63) // 64)
EPS = 1e-6

kernel_name = "hybrid_rglru_pool_sgu_macaron"


def rmsnorm(x, g):
    x32 = x.astype(jnp.float32)
    y = x32 * lax.rsqrt(jnp.mean(x32 * x32, axis=-1, keepdims=True) + EPS)
    return (y * g.astype(jnp.float32)).astype(x.dtype)


def swiglu(h, w_in, w_out):
    g, u = jnp.split(h @ w_in, 2, axis=-1)
    return (jax.nn.silu(g) * u) @ w_out


def causal_dwconv(x, w, b):
    S = x.shape[1]
    xp = jnp.pad(x, ((0, 0), (CONV_WIDTH - 1, 0), (0, 0)))
    y = b
    for k in range(CONV_WIDTH):
        y = y + xp[:, k:k + S] * w[k]
    return y


def rglru_branch(gate, xa, conv_w, conv_b, w_a, b_a, w_x, b_x, lam):
    B, S, _ = xa.shape
    xc = causal_dwconv(xa, conv_w, conv_b)
    xh = xc.reshape(B, S, RNN_HEADS, RNN_HEAD_DIM)
    r = jax.nn.sigmoid(jnp.einsum('bshi,hij->bshj', xh, w_a) + b_a)
    i = jax.nn.sigmoid(jnp.einsum('bshi,hij->bshj', xh, w_x) + b_x)
    r32 = r.astype(jnp.float32).reshape(B, S, D_RNN)
    i32 = i.astype(jnp.float32).reshape(B, S, D_RNN)
    x32 = xc.astype(jnp.float32)
    log_a = -LRU_C * r32 * jax.nn.softplus(-lam.astype(jnp.float32))
    a = jnp.exp(log_a)
    mult = jnp.sqrt(-jnp.expm1(2.0 * log_a))
    bvals = mult * (i32 * x32)

    def combine(left, right):
        a_l, b_l = left
        a_r, b_r = right
        return a_l * a_r, a_r * b_l + b_r

    _, h = lax.associative_scan(combine, (a, bvals), axis=1)
    return jax.nn.gelu(gate) * h.astype(gate.dtype)


def causal_window_mean(x32, w):
    S = x32.shape[1]
    cs = jnp.cumsum(x32, axis=1)
    prev = jnp.pad(cs, ((0, 0), (w, 0), (0, 0)))[:, :S]
    count = jnp.minimum(jnp.arange(S) + 1, w).astype(jnp.float32)
    return (cs - prev) / count[None, :, None]


def pool_branch(xp, pool_w, pool_scale):
    x32 = xp.astype(jnp.float32)
    outs = []
    for g, w in enumerate(POOL_WINDOWS):
        xg = x32[..., g * POOL_GROUP_DIM:(g + 1) * POOL_GROUP_DIM]
        d = (causal_window_mean(xg, w) - xg).astype(xp.dtype)
        outs.append(d @ pool_w[g])
    return jnp.concatenate(outs, axis=-1) * pool_scale


def sgu_branch(u, v, sgu_norm, sgu_w, sgu_b):
    B, S, _ = u.shape
    u = jax.nn.gelu(u)
    v = rmsnorm(jax.nn.gelu(v), sgu_norm)
    vh = v.reshape(B, S // CHUNK, CHUNK, SGU_HEADS, SGU_HEAD_DIM)
    mask = jnp.tril(jnp.ones((CHUNK, CHUNK), dtype=bool))
    ws = jnp.where(mask[None], sgu_w, jnp.zeros_like(sgu_w))
    z = jnp.einsum('hts,bnshd->bnthd', ws, vh) + jnp.transpose(sgu_b)[None, None, :, :, None]
    return u * z.reshape(B, S, D_SGU)


def setup_inputs(seed: int = 0) -> dict:
    key = jax.random.key(seed)
    ks = jax.random.split(key, 24)
    f32 = jnp.float32

    def nrm(k, shape, scale):
        return jax.random.normal(k, shape, f32) * scale

    def gain(k, shape):
        return 1.0 + 0.05 * jax.random.normal(k, shape, f32)

    u_a = jax.random.uniform(ks[9], (DEPTH, D_RNN), f32, 0.9, 0.999)
    s = u_a ** (1.0 / LRU_C)
    lru_lambda = jnp.log(s) - jnp.log1p(-s)

    return {
        "x": jax.random.normal(ks[0], (BATCH, SEQ, D_MODEL), f32),
        "ffn1_norm": gain(ks[1], (DEPTH, D_MODEL)),
        "ffn1_w_in": nrm(ks[2], (DEPTH, D_MODEL, 2 * D_FF), D_MODEL ** -0.5),
        "ffn1_w_out": nrm(ks[3], (DEPTH, D_FF, D_MODEL), D_FF ** -0.5),
        "mix_norm": gain(ks[4], (DEPTH, D_MODEL)),
        "w_in": nrm(ks[5], (DEPTH, D_MODEL, D_IN), D_MODEL ** -0.5),
        "conv_w": nrm(ks[6], (DEPTH, CONV_WIDTH, D_RNN), CONV_WIDTH ** -0.5),
        "conv_b": nrm(ks[7], (DEPTH, D_RNN), 0.02),
        "rg_w_a": nrm(ks[8], (DEPTH, RNN_HEADS, RNN_HEAD_DIM, RNN_HEAD_DIM), RNN_HEAD_DIM ** -0.5),
        "rg_b_a": nrm(ks[10], (DEPTH, RNN_HEADS, RNN_HEAD_DIM), 0.02),
        "rg_w_x": nrm(ks[11], (DEPTH, RNN_HEADS, RNN_HEAD_DIM, RNN_HEAD_DIM), RNN_HEAD_DIM ** -0.5),
        "rg_b_x": nrm(ks[12], (DEPTH, RNN_HEADS, RNN_HEAD_DIM), 0.02),
        "lru_lambda": lru_lambda,
        "pool_w": nrm(ks[13], (DEPTH, POOL_GROUPS, POOL_GROUP_DIM, POOL_GROUP_DIM), POOL_GROUP_DIM ** -0.5),
        "pool_scale": gain(ks[14], (DEPTH, D_POOL)),
        "sgu_norm": gain(ks[15], (DEPTH, D_SGU)),
        "sgu_w": nrm(ks[16], (DEPTH, SGU_HEADS, CHUNK, CHUNK), CHUNK ** -0.5),
        "sgu_b": gain(ks[17], (DEPTH, SGU_HEADS, CHUNK)),
        "w_out": nrm(ks[18], (DEPTH, D_MIX, D_MODEL), D_MIX ** -0.5),
        "ffn2_norm": gain(ks[19], (DEPTH, D_MODEL)),
        "ffn2_w_in": nrm(ks[20], (DEPTH, D_MODEL, 2 * D_FF), D_MODEL ** -0.5),
        "ffn2_w_out": nrm(ks[21], (DEPTH, D_FF, D_MODEL), D_FF ** -0.5),
        "final_norm": gain(ks[22], (D_MODEL,)),
    }


def reference(x, ffn1_norm, ffn1_w_in, ffn1_w_out, mix_norm, w_in, conv_w, conv_b,
              rg_w_a, rg_b_a, rg_w_x, rg_b_x, lru_lambda, pool_w, pool_scale,
              sgu_norm, sgu_w, sgu_b, w_out, ffn2_norm, ffn2_w_in, ffn2_w_out, final_norm):
    s1 = D_RNN
    s2 = 2 * D_RNN
    s3 = s2 + D_POOL
    s4 = s3 + D_SGU
    for l in range(DEPTH):
        x = x + 0.5 * swiglu(rmsnorm(x, ffn1_norm[l]), ffn1_w_in[l], ffn1_w_out[l])
        h = rmsnorm(x, mix_norm[l])
        p = h @ w_in[l]
        gate_a, xa, xp, u, v = jnp.split(p, [s1, s2, s3, s4], axis=-1)
        ya = rglru_branch(gate_a, xa, conv_w[l], conv_b[l], rg_w_a[l], rg_b_a[l],
                          rg_w_x[l], rg_b_x[l], lru_lambda[l])
        yb = pool_branch(xp, pool_w[l], pool_scale[l])
        yc = sgu_branch(u, v, sgu_norm[l], sgu_w[l], sgu_b[l])
        x = x + jnp.concatenate([ya, yb, yc], axis=-1) @ w_out[l]
        x = x + 0.5 * swiglu(rmsnorm(x, ffn2_norm[l]), ffn2_w_in[l], ffn2_w_out[l])
    return rmsnorm(x, final_norm)
```

```cpp
#include <hip/hip_runtime.h>
#include <hip/hip_cooperative_groups.h>
#include <cstdio>
namespace cg = cooperative_groups;

#define LAS __attribute__((address_space(3)))
typedef unsigned short bf16_t;
typedef short bf16x8 __attribute__((ext_vector_type(8)));
typedef float f32x4 __attribute__((ext_vector_type(4)));
typedef unsigned u32x4 __attribute__((ext_vector_type(4)));
typedef unsigned u32x2 __attribute__((ext_vector_type(2)));
typedef unsigned u32s;
constexpr float SS_SCALE = 16384.0f, SS_INV = 1.0f / 16384.0f;

constexpr int D = 1024, BATCH = 8, SEQ = 8192, M = BATCH * SEQ, DEPTH = 2;
constexpr int DRNN = 512, DPOOL = 256, DSGU = 256, DIN = 1792, DFF = 2752, DFFP = 2816, NFF = 2 * DFFP;
constexpr int TCH = 256, NCH = SEQ / TCH;
constexpr float EPS = 1e-6f;
constexpr int NTHREADS = 512;
constexpr int LDS_RS = 131072 + 64;
constexpr int LDS_BYTES = 131072 + 64 + 1024;

constexpr size_t MiB = 1u << 20;
constexpr size_t WS_WL = 40 * MiB;
constexpr size_t WO_FFNIN0 = 0, WO_FFNOUT0 = 11 * MiB, WO_FFNIN1 = 17 * MiB, WO_FFNOUT1 = 28 * MiB, WO_WIN = 34 * MiB, WO_WOUT = 38 * MiB;
constexpr size_t WS_SMALL = 80 * MiB, SMALL_L = 512 * 1024;
constexpr size_t SO_RGA = 0, SO_RGX = 65536, SO_POOL = 131072, SO_SGU = 163840;
constexpr size_t WS_ROWSS = 81 * MiB;
constexpr size_t WS_SUMA = 85 * MiB, WS_SUMH = 85 * MiB + 512 * 1024;
constexpr size_t WS_XB = 86 * MiB;
constexpr size_t WS_ACT = 214 * MiB;
constexpr size_t WS_P = WS_ACT, WS_Y = WS_ACT + 224 * MiB;
constexpr size_t WS_END = 566 * MiB;
constexpr size_t WS_CTL = 84 * MiB + 768 * 1024, CTL_BYTES = 16384;

__device__ __forceinline__ unsigned cvt_pk_bf16(float lo, float hi) { unsigned r; asm("v_cvt_pk_bf16_f32 %0, %1, %2" : "=v"(r) : "v"(lo), "v"(hi)); return r; }
__device__ __forceinline__ f32x4 unpack4(u32x2 w) { f32x4 v; v.x = __uint_as_float(w.x << 16); v.y = __uint_as_float(w.x & 0xffff0000u); v.z = __uint_as_float(w.y << 16); v.w = __uint_as_float(w.y & 0xffff0000u); return v; }
__device__ __forceinline__ u32x2 pack4(f32x4 v) { u32x2 w; w.x = cvt_pk_bf16(v.x, v.y); w.y = cvt_pk_bf16(v.z, v.w); return w; }
__device__ __forceinline__ float sigmoidf_(float z) { return __builtin_amdgcn_rcpf(1.0f + __expf(-z)); }
__device__ __forceinline__ float gelu_t(float x) { const float w = __builtin_fmaf(x * x, -0.1029432395f, -2.3022082003f); return x * __builtin_amdgcn_rcpf(1.0f + __builtin_amdgcn_exp2f(x * w)); }
__device__ __forceinline__ f32x4 gelu4(f32x4 v) { f32x4 o; o.x = gelu_t(v.x); o.y = gelu_t(v.y); o.z = gelu_t(v.z); o.w = gelu_t(v.w); return o; }
__device__ __forceinline__ bf16x8 mk8(u32x2 lo, u32x2 hi) { u32x4 v; v.x = lo.x; v.y = lo.y; v.z = hi.x; v.w = hi.y; return __builtin_bit_cast(bf16x8, v); }
__device__ __forceinline__ int fresh_lane() { int lane; asm volatile("v_mbcnt_lo_u32_b32 %0, -1, 0\n\tv_mbcnt_hi_u32_b32 %0, -1, %0" : "=v"(lane)); return lane; }
__device__ __forceinline__ int fresh_tid(int wave_s) { return wave_s * 64 + fresh_lane(); }
__device__ __forceinline__ float shfl_xor_l(float v, int mask, int lane) { return __builtin_bit_cast(float, __builtin_amdgcn_ds_bpermute((lane ^ mask) << 2, __builtin_bit_cast(int, v))); }
template <int SH> __device__ __forceinline__ float dpp_shr(float old, float v) {
    return __builtin_bit_cast(float, __builtin_amdgcn_update_dpp(__builtin_bit_cast(int, old), __builtin_bit_cast(int, v), 0x110 + SH, 0xf, 0xf, false));
}

template <int K> __device__ __forceinline__ float dpp_ror(float v) {
    return __builtin_bit_cast(float, __builtin_amdgcn_update_dpp(0, __builtin_bit_cast(int, v), 0x120 + K, 0xf, 0xf, false));
}
__device__ __forceinline__ float dpp_ror1(float v) {
    return __builtin_bit_cast(float, __builtin_amdgcn_update_dpp(0, __builtin_bit_cast(int, v), 0x121, 0xf, 0xf, false));
}

#ifndef RESID_DEPTH
#define RESID_DEPTH 8
#endif
namespace pg8 {
constexpr int BM = 256, BK = 64, HALF = 128, HTB = HALF * BK * 2, STAGE_BYTES = 8 * HTB, NXCD = 8, WGM = 8;
__host__ __device__ __forceinline__ int lds_byte(int r, int c) { const int st = (r >> 4) * 2 + (c >> 5), rr = r & 15, cc = c & 31, ob = rr * 64 + cc * 2; return st * 1024 + (ob ^ (((ob >> 9) & 1) << 5)); }
__host__ __device__ __forceinline__ void stage_rc(int b, int& R, int& C) { const int st = b / 1024, sb = b % 1024, swz = sb ^ (((sb >> 9) & 1) << 5); R = (st >> 1) * 16 + swz / 64; C = (st & 1) * 32 + (swz % 64) / 2; }
__host__ __device__ __forceinline__ int perm32(int rho) { const int n = rho >> 4, i = rho & 15; return 8 * (i >> 2) + 4 * n + (i & 3); }
struct Unit { int pm, pn; };
struct Gemm { const bf16_t* A; const bf16_t* Bt; int M, N, K; };
struct StaticOrder {
    int nM, nN, nwg, G, c;
    __device__ void init(int M_, int N_, int G_, int c_) { nM = M_ / BM; nN = N_ / BM; nwg = nM * nN; G = G_; c = c_; }
    __device__ bool next(int i, Unit& u) const {
        const long L = (long)i * G + c; if (L >= nwg) return false;
        int wgid = (int)L; { const int q = nwg / NXCD, r = nwg % NXCD, xcd = wgid % NXCD, off = wgid / NXCD; wgid = (xcd < r ? xcd * (q + 1) : r * (q + 1) + (xcd - r) * q) + off; }
        const int nig = WGM * nN, gid = wgid / nig, fm = gid * WGM, gsz = (nM - fm) < WGM ? (nM - fm) : WGM;
        u.pm = fm + ((wgid % nig) % gsz); u.pn = (wgid % nig) / gsz; return true;
    }
    template <int NN> __device__ __forceinline__ bool next_c(int i, Unit& u) const {
        const int L = i * G + c; if (L >= nwg) return false;
        const int wgid = (L & 7) * (nwg >> 3) + (L >> 3);
        constexpr int nig = WGM * NN; const int gid = wgid / nig, rem = wgid - gid * nig;
        u.pm = gid * WGM + (rem & (WGM - 1)); u.pn = rem / WGM; return true;
    }
};

template <class Epi, bool ABLK = false, bool PEEL = true, int NN = 0>
__device__ __forceinline__ void gemm_phase(LAS unsigned char* lds, const Gemm g, const StaticOrder& S, const Epi& E, int wave_s) {
    const int tid_ = fresh_tid(wave_s);
    const int tid = tid_, wid = __builtin_amdgcn_readfirstlane(tid >> 6), lane = tid & 63, wr = wid >> 2, wc = wid & 3, fr = lane & 15, fq = lane >> 4;
    const int K = g.K, nt = K / BK;
    unsigned voffA[2], voffB[2];
#pragma unroll
    for (int i = 0; i < 2; ++i) { int R, C; stage_rc(tid * 16 + i * 8192, R, C); const int Rb = Epi::PERM ? ((R & ~31) + perm32(R & 31)) : R;
        voffA[i] = ABLK ? (unsigned)(R * BK + C) * 2u : (unsigned)(R * K + C) * 2u; voffB[i] = (unsigned)(Rb * K + C) * 2u; }
    const size_t kstep = (size_t)(BK * 2);
    const size_t hstep = (size_t)HALF * K * 2;
    const size_t tstep = 2 * hstep;
    const size_t kstepA = ABLK ? (size_t)(BM * BK * 2) : kstep, hstepA = ABLK ? (size_t)(HALF * BK * 2) : hstep;
    const unsigned ldsw = (unsigned)wid * 1024u;
    const int aoff = lds_byte(wr * 64 + fr, fq * 8), boff = lds_byte(wc * 32 + fr, fq * 8);
#define PG8_SA(b, h) (((b) * 2 + (h)) * HTB)
#define PG8_SB(b, h) ((4 + (b) * 2 + (h)) * HTB)
#define PG8_STAGE(bufoff, gbase, voff) do { _Pragma("unroll") for (int _i = 0; _i < 2; ++_i) \
        __builtin_amdgcn_global_load_lds((const unsigned*)((const char*)(gbase) + (voff)[_i]), (LAS unsigned*)(lds + (bufoff) + ldsw + _i * 8192), 16, 0, 0); } while (0)
#define PG8_LDA(dst, b, h) do { _Pragma("unroll") for (int m = 0; m < 4; ++m) _Pragma("unroll") for (int k = 0; k < 2; ++k) dst[m][k] = *(const LAS bf16x8*)(lds + PG8_SA(b, h) + aoff + m * 2048 + k * 1024); } while (0)
#define PG8_LDB(dst, b, h) do { _Pragma("unroll") for (int n = 0; n < 2; ++n) _Pragma("unroll") for (int k = 0; k < 2; ++k) dst[n][k] = *(const LAS bf16x8*)(lds + PG8_SB(b, h) + boff + n * 2048 + k * 1024); } while (0)
#define PG8_MMA(ai, bj, At, Bt, ZC) do { __builtin_amdgcn_s_setprio(1); _Pragma("unroll") for (int m = 0; m < 4; ++m) _Pragma("unroll") for (int n = 0; n < 2; ++n) _Pragma("unroll") for (int k = 0; k < 2; ++k) \
        acc[ai][bj][m][n] = __builtin_amdgcn_mfma_f32_16x16x32_bf16(Bt[n][k], At[m][k], ((ZC) && k == 0) ? (f32x4){0.f, 0.f, 0.f, 0.f} : acc[ai][bj][m][n], 0, 0, 0); __builtin_amdgcn_s_setprio(0); } while (0)
#define PG8_WAIT_V(n) asm volatile("s_waitcnt vmcnt(" #n ")" ::: "memory")
#define PG8_WAIT_L(n) asm volatile("s_waitcnt lgkmcnt(" #n ")" ::: "memory")
#define PG8_BAR __builtin_amdgcn_s_barrier()
#define PG8_SCHED __builtin_amdgcn_sched_barrier(0)
#define PG8_BODY(FK) do { \
            const char* a1 = cA + (size_t)(t + 1) * kstepA; \
            const char* a2 = last ? nA : cA + (size_t)(t + 2) * kstepA; const char* b2 = last ? nB : cB + (size_t)(t + 2) * kstep; \
            const char* a3 = a2 + kstepA; const char* b3 = b2 + kstep; \
            if (last) E.stage(lds, cur, wid, fresh_lane()); \
            PG8_LDB(B0, 0, 0); PG8_SCHED; PG8_LDA(At, 0, 0); PG8_STAGE(PG8_SA(1, 1), a1 + hstepA, voffA); \
            PG8_WAIT_L(8); PG8_BAR; PG8_WAIT_L(0); PG8_MMA(0, 0, At, B0, FK); PG8_BAR; PG8_SCHED; \
            PG8_LDB(B1, 0, 1); PG8_STAGE(PG8_SB(0, 0), b2, voffB); \
            PG8_BAR; PG8_WAIT_L(0); PG8_MMA(0, 1, At, B1, FK); PG8_BAR; \
            PG8_LDA(At, 0, 1); PG8_STAGE(PG8_SA(0, 0), a2, voffA); \
            PG8_BAR; PG8_WAIT_L(0); PG8_MMA(1, 0, At, B0, FK); PG8_BAR; PG8_SCHED; \
            PG8_STAGE(PG8_SB(0, 1), b2 + hstep, voffB); \
            PG8_WAIT_V(6); PG8_BAR; PG8_MMA(1, 1, At, B1, FK); PG8_BAR; \
            PG8_LDB(B0, 1, 0); PG8_SCHED; PG8_LDA(At, 1, 0); PG8_STAGE(PG8_SA(0, 1), a2 + hstepA, voffA); \
            PG8_WAIT_L(8); PG8_BAR; PG8_WAIT_L(0); PG8_MMA(0, 0, At, B0, false); PG8_BAR; PG8_SCHED; \
            PG8_LDB(B1, 1, 1); PG8_STAGE(PG8_SB(1, 0), b3, voffB); \
            PG8_BAR; PG8_WAIT_L(0); PG8_MMA(0, 1, At, B1, false); PG8_BAR; \
            PG8_LDA(At, 1, 1); PG8_STAGE(PG8_SA(1, 0), a3, voffA); \
            PG8_BAR; PG8_WAIT_L(0); PG8_MMA(1, 0, At, B0, false); PG8_BAR; PG8_SCHED; \
            PG8_STAGE(PG8_SB(1, 1), b3 + hstep, voffB); \
            PG8_WAIT_V(6); PG8_BAR; PG8_MMA(1, 1, At, B1, false); PG8_BAR; \
        } while (0)
    Unit cur, nxt; int ui = 0;
    if (!(NN ? S.template next_c<(NN ? NN : 1)>(0, cur) : S.next(0, cur))) return;
    f32x4 acc[2][2][4][2];
    bf16x8 At[4][2], B0[2][2], B1[2][2];
    const char* cA = (const char*)g.A + (size_t)cur.pm * tstep; const char* cB = (const char*)g.Bt + (size_t)cur.pn * tstep;
    PG8_STAGE(PG8_SB(0, 0), cB, voffB); PG8_STAGE(PG8_SA(0, 0), cA, voffA); PG8_STAGE(PG8_SB(0, 1), cB + hstep, voffB); PG8_STAGE(PG8_SA(0, 1), cA + hstepA, voffA);
    if (wr == 1) PG8_BAR;
    PG8_WAIT_V(4); PG8_BAR;
    PG8_STAGE(PG8_SB(1, 0), cB + kstep, voffB); PG8_STAGE(PG8_SA(1, 0), cA + kstepA, voffA); PG8_STAGE(PG8_SB(1, 1), cB + hstep + kstep, voffB);
    PG8_WAIT_V(6); PG8_BAR;
    for (;;) {
        const bool has_next = NN ? S.template next_c<(NN ? NN : 1)>(ui + 1, nxt) : S.next(ui + 1, nxt);
        const char* nA = has_next ? (const char*)g.A + (size_t)nxt.pm * tstep : cA; const char* nB = has_next ? (const char*)g.Bt + (size_t)nxt.pn * tstep : cB;
        if constexpr (PEEL) {
            PG8_SCHED;
            { const int t = 0; const bool last = false; PG8_BODY(true); }
            for (int t = 2; t < nt; t += 2) { const bool last = (t == nt - 2); PG8_BODY(false); }
        } else {
            if (ui > 0 || true) {
#pragma unroll
                for (int a_ = 0; a_ < 2; ++a_)
#pragma unroll
                    for (int b_ = 0; b_ < 2; ++b_)
#pragma unroll
                        for (int m_ = 0; m_ < 4; ++m_)
#pragma unroll
                            for (int n_ = 0; n_ < 2; ++n_) acc[a_][b_][m_][n_] = (f32x4){0.f, 0.f, 0.f, 0.f};
            }
            for (int t = 0; t < nt; t += 2) { const bool last = (t == nt - 2); PG8_BODY(false); }
        }
        PG8_SCHED;
        { const int l2_ = fresh_lane(); E(acc, cur, wr, wc, l2_ & 15, l2_ >> 4, lds); }
        PG8_SCHED;
        if (!has_next) break;
        cur = nxt; cA = nA; cB = nB; ++ui;
    }
    PG8_WAIT_V(0);
    if (wr == 0) PG8_BAR;
    PG8_BAR;
#undef PG8_BODY
#undef PG8_SA
#undef PG8_SB
#undef PG8_STAGE
#undef PG8_LDA
#undef PG8_LDB
#undef PG8_MMA
#undef PG8_WAIT_V
#undef PG8_WAIT_L
#undef PG8_BAR
#undef PG8_SCHED
}

struct EpiSwiGLU {
    static constexpr bool PERM = true, IDEMPOTENT = true;
    bf16_t* O; const u32s* rowss;
    __device__ __forceinline__ void stage(LAS unsigned char* lds, const Unit& u, int wid, int lane) const {
        if (wid < 4) __builtin_amdgcn_global_load_lds((const unsigned*)(rowss + u.pm * BM + wid * 64 + lane), (LAS unsigned*)(lds + LDS_RS + wid * 256), 4, 0, 0);
    }
    __device__ __forceinline__ void operator()(const f32x4 (&acc)[2][2][4][2], const Unit& u, int wr, int wc, int fr, int fq, LAS unsigned char* lds) const {
        const int row0 = u.pm * BM + wr * 64 + fr, col0 = u.pn * HALF + wc * 32 + 8 * fq;
        u32s rs[2][4];
#pragma unroll
        for (int ai = 0; ai < 2; ++ai)
#pragma unroll
            for (int m = 0; m < 4; ++m) rs[ai][m] = ((const LAS u32s*)(lds + LDS_RS))[wr * 64 + ai * HALF + m * 16 + fr];
#pragma unroll
        for (int ai = 0; ai < 2; ++ai)
#pragma unroll
            for (int m = 0; m < 4; ++m) {
                const int row = row0 + ai * HALF + m * 16;
                const float kk = (float)rs[ai][m] * (SS_INV / D) + EPS;
                const float rstd = __builtin_amdgcn_rsqf(kk);
                u32x4 w; unsigned* wp = (unsigned*)&w;
                const float c1 = -1.4426950409f * rstd;
#pragma unroll
                for (int n = 0; n < 2; ++n) {
                    const f32x4 ag = acc[ai][0][m][n], au = acc[ai][1][m][n]; const f32x4 t = ag * c1, p = ag * au; f32x4 o;
#pragma unroll
                    for (int e = 0; e < 4; ++e) o[e] = p[e] * __builtin_amdgcn_rcpf(__builtin_fmaf(__builtin_amdgcn_exp2f(t[e]), kk, kk));
                    wp[2 * n] = cvt_pk_bf16(o[0], o[1]); wp[2 * n + 1] = cvt_pk_bf16(o[2], o[3]);
                }
                *(u32x4*)(O + ((((size_t)u.pm * (DFFP / BK) + (col0 >> 6)) * BM + (row & (BM - 1))) * BK + (col0 & (BK - 1)))) = w;
            }
    }
};
struct EpiResid {
    static constexpr bool PERM = true, IDEMPOTENT = false;
    bf16_t* xb; u32s* rowss_out; float alpha;
    __device__ __forceinline__ void stage(LAS unsigned char*, const Unit&, int, int) const {}
    __device__ __forceinline__ void operator()(const f32x4 (&acc)[2][2][4][2], const Unit& u, int wr, int wc, int fr, int fq, LAS unsigned char*) const {
        const int row0 = u.pm * BM + wr * 64 + fr, col0 = u.pn * BM + wc * 32 + 8 * fq;
        u32x4 ring[RESID_DEPTH][2];
#pragma unroll
        for (int g = 0; g < RESID_DEPTH; ++g) { const int rown = row0 + (g >> 2) * HALF + (g & 3) * 16;
#pragma unroll
            for (int bj = 0; bj < 2; ++bj) ring[g][bj] = *(const u32x4*)(xb + (size_t)rown * D + col0 + bj * HALF); }
#pragma unroll
        for (int g = 0; g < 8; ++g) {
            const int ai = g >> 2, m = g & 3;
            const int row = row0 + ai * HALF + m * 16; const size_t off = (size_t)row * D + col0; float ss = 0.f;
            u32x4 bw[2];
#pragma unroll
            for (int bj = 0; bj < 2; ++bj) bw[bj] = ring[g % RESID_DEPTH][bj];
            if (g + RESID_DEPTH < 8) { const int rown = row0 + ((g + RESID_DEPTH) >> 2) * HALF + ((g + RESID_DEPTH) & 3) * 16;
#pragma unroll
                for (int bj = 0; bj < 2; ++bj) ring[g % RESID_DEPTH][bj] = *(const u32x4*)(xb + (size_t)rown * D + col0 + bj * HALF); }
#pragma unroll
            for (int bj = 0; bj < 2; ++bj) {
                const f32x4 o0 = unpack4((u32x2){bw[bj].x, bw[bj].y}) + alpha * acc[ai][bj][m][0];
                const f32x4 o1 = unpack4((u32x2){bw[bj].z, bw[bj].w}) + alpha * acc[ai][bj][m][1];
                const u32x2 p0 = pack4(o0), p1 = pack4(o1);
                *(u32x4*)(xb + off + bj * HALF) = (u32x4){p0.x, p0.y, p1.x, p1.y};
                ss += ((o0[0] * o0[0] + o0[1] * o0[1]) + (o0[2] * o0[2] + o0[3] * o0[3])) + ((o1[0] * o1[0] + o1[1] * o1[1]) + (o1[2] * o1[2] + o1[3] * o1[3]));
            }
            { const int ln_ = fq * 16 + fr; ss += shfl_xor_l(ss, 16, ln_); ss += shfl_xor_l(ss, 32, ln_); }
            if (fq == 0) atomicAdd(rowss_out + row, (u32s)(ss * SS_SCALE));
        }
    }
};
struct EpiP {
    static constexpr bool PERM = true, IDEMPOTENT = false;
    bf16_t* O; const u32s* rowss;
    __device__ __forceinline__ void stage(LAS unsigned char* lds, const Unit& u, int wid, int lane) const {
        if (wid < 4) __builtin_amdgcn_global_load_lds((const unsigned*)(rowss + u.pm * BM + wid * 64 + lane), (LAS unsigned*)(lds + LDS_RS + wid * 256), 4, 0, 0);
    }
    __device__ __forceinline__ void operator()(const f32x4 (&acc)[2][2][4][2], const Unit& u, int wr, int wc, int fr, int fq, LAS unsigned char* lds) const {
        const int row0 = u.pm * BM + wr * 64 + fr, col0 = u.pn * BM + wc * 32 + 8 * fq;
        u32s rs[2][4];
#pragma unroll
        for (int ai = 0; ai < 2; ++ai)
#pragma unroll
            for (int m = 0; m < 4; ++m) rs[ai][m] = ((const LAS u32s*)(lds + LDS_RS))[wr * 64 + ai * HALF + m * 16 + fr];
#pragma unroll
        for (int ai = 0; ai < 2; ++ai)
#pragma unroll
            for (int m = 0; m < 4; ++m) {
                const int row = row0 + ai * HALF + m * 16;
                const float rstd = __builtin_amdgcn_rsqf((float)rs[ai][m] * (SS_INV / D) + EPS);
#pragma unroll
                for (int bj = 0; bj < 2; ++bj) {
                    const f32x4 v0 = acc[ai][bj][m][0] * rstd, v1 = acc[ai][bj][m][1] * rstd;
                    u32x4 w; w.x = cvt_pk_bf16(v0[0], v0[1]); w.y = cvt_pk_bf16(v0[2], v0[3]); w.z = cvt_pk_bf16(v1[0], v1[1]); w.w = cvt_pk_bf16(v1[2], v1[3]);
                    *(u32x4*)(O + (size_t)row * DIN + col0 + bj * HALF) = w;
                }
            }
    }
};
}

#define RLX_AGENT __ATOMIC_RELAXED, __HIP_MEMORY_SCOPE_AGENT
#define XB_TMO      128
#define XB_XCNT(j)  (256  + 64 * (j))
#define XB_XSUB(j)  (1280 + 64 * (j))
#define XB_XGEN(j)  (2304 + 64 * (j))
#define XB_TOP      3328
#define XB_TOPGEN   3392
#define XCD_BAR_WORDS 3456
#define XB_SPIN_CAP (1u << 18)

__device__ __forceinline__ unsigned xb_ld(unsigned* p)              { return __hip_atomic_load(p, __ATOMIC_RELAXED, __HIP_MEMORY_SCOPE_AGENT); }
__device__ __forceinline__ unsigned xb_add(unsigned* p, unsigned v) { return __hip_atomic_fetch_add(p, v, __ATOMIC_RELAXED, __HIP_MEMORY_SCOPE_AGENT); }
__device__ __forceinline__ unsigned xb_xcc_id() { return (unsigned)__builtin_amdgcn_s_getreg((3 << 11) | 20) & 0xFu; }
#define XB_SPIN(cond, bar) do { unsigned _sp = 0; while (cond) { __builtin_amdgcn_s_sleep(1); \
    if ((++_sp & 255u) == 0u) { if (xb_ld(&(bar)[XB_TMO])) break; if (_sp > XB_SPIN_CAP) { atomicAdd(&(bar)[XB_TMO], 1u); break; } } } } while (0)

struct XcdBarrier {
    unsigned* bar; unsigned x; int wave;
    volatile LAS unsigned* st;
};

__device__ __forceinline__ XcdBarrier xcd_barrier_post(unsigned* bar, volatile LAS unsigned* st, int wave_s) {
    XcdBarrier b; b.bar = bar; b.x = xb_xcc_id(); b.st = st; b.wave = wave_s;
    if (wave_s == 0 && fresh_lane() == 0) (void)xb_add(&bar[XB_XCNT(b.x)], 1u);
    return b;
}
__device__ __forceinline__ void xcd_barrier_complete(unsigned* bar, unsigned x, unsigned& nloc, unsigned& nx) {
    const unsigned G = gridDim.x * gridDim.y * gridDim.z;
    unsigned sum, cnt, mine, sp = 0u;
    for (;;) {
        sum = 0u; cnt = 0u; mine = 0u;
#pragma unroll
        for (unsigned j = 0; j < 16; ++j) { const unsigned c = xb_ld(&bar[XB_XCNT(j)]); sum += c; cnt += (c > 0u) ? 1u : 0u; mine = (j == x) ? c : mine; }
        if (sum == G) break;
        __builtin_amdgcn_s_sleep(1);
        if ((++sp & 255u) == 0u) { if (xb_ld(&bar[XB_TMO])) break; if (sp > XB_SPIN_CAP) { atomicAdd(&bar[XB_TMO], 1u); break; } }
    }
    nloc = mine > 0u ? mine : 1u; nx = cnt > 0u ? cnt : 1u;
}

__device__ __forceinline__ void xcd_barrier(const XcdBarrier& b) {
    asm volatile("s_waitcnt vmcnt(0)" ::: "memory");
    __syncthreads();
    if (b.wave == 0 && fresh_lane() == 0) {
        unsigned* bar = b.bar;
        __builtin_amdgcn_s_waitcnt(0);
        unsigned nloc = b.st[0], nx = b.st[1];
        if (nloc == 0u) { xcd_barrier_complete(bar, b.x, nloc, nx); b.st[0] = nloc; b.st[1] = nx; }
        const unsigned old = xb_add(&bar[XB_XSUB(b.x)], 1u);
        const unsigned gen = old / nloc;
        if (old + 1u == (gen + 1u) * nloc) {
            __builtin_amdgcn_fence(__ATOMIC_RELEASE, "agent");
            asm volatile("s_waitcnt vmcnt(0)" ::: "memory");
            const unsigned og = xb_add(&bar[XB_TOP], 1u);
            const unsigned tg = og / nx;
            if (og + 1u == (tg + 1u) * nx) xb_add(&bar[XB_TOPGEN], 1u);
            else XB_SPIN(xb_ld(&bar[XB_TOPGEN]) == tg, bar);
            __builtin_amdgcn_fence(__ATOMIC_ACQUIRE, "agent");
            xb_add(&bar[XB_XGEN(b.x)], 1u);
            asm volatile("s_waitcnt vmcnt(0)" ::: "memory");
        } else {
            XB_SPIN(xb_ld(&bar[XB_XGEN(b.x)]) == gen, bar);
            __builtin_amdgcn_fence(__ATOMIC_ACQUIRE, "agent");
            asm volatile("s_waitcnt vmcnt(0)" ::: "memory");
        }
    }
    __syncthreads();
}


struct Args { const float* in[23]; float* out; unsigned char* ws; };
enum { I_X = 0, I_F1N, I_F1WI, I_F1WO, I_MIXN, I_WIN, I_CONVW, I_CONVB, I_RGWA, I_RGBA, I_RGWX, I_RGBX, I_LAM, I_POOLW, I_POOLS, I_SGUN, I_SGUW, I_SGUB, I_WOUT, I_F2N, I_F2WI, I_F2WO, I_FINN };

__device__ __forceinline__ void transpose_block(const float* src, int lds_, const float* gain, bf16_t* dst, int ldd, int k0, int nd0, int sc0, bool valid, LAS float* scr, int lane) {
    const int c = lane & 7;
    if (!valid) {
#pragma unroll
        for (int j = 0; j < 4; ++j) { const int n = (lane >> 3) + 8 * j; *(u32x4*)(dst + (size_t)(nd0 + n) * ldd + k0 + 8 * c) = (u32x4){0u, 0u, 0u, 0u}; }
        return;
    }
#pragma unroll 16
    for (int i = 0; i < 32; ++i) { const int kk = 2 * i + (lane >> 5); float v = src[(size_t)(k0 + kk) * lds_ + sc0 + (lane & 31)]; if (gain) v *= gain[k0 + kk]; scr[kk * 33 + (lane & 31)] = v; }
    asm volatile("s_waitcnt lgkmcnt(0)" ::: "memory");
#pragma unroll
    for (int j = 0; j < 4; ++j) { const int n = (lane >> 3) + 8 * j; const LAS float* s = scr + (8 * c) * 33 + n;
        u32x4 o; o.x = cvt_pk_bf16(s[0 * 33], s[1 * 33]); o.y = cvt_pk_bf16(s[2 * 33], s[3 * 33]); o.z = cvt_pk_bf16(s[4 * 33], s[5 * 33]); o.w = cvt_pk_bf16(s[6 * 33], s[7 * 33]);
        *(u32x4*)(dst + (size_t)(nd0 + n) * ldd + k0 + 8 * c) = o; }
    asm volatile("s_waitcnt lgkmcnt(0)" ::: "memory");
}

__device__ __forceinline__ void prologue(const Args& a, LAS unsigned char* lds, int wave_s) {
    const int tid_ = fresh_tid(wave_s);
    const int tid = tid_, lane = tid & 63, wave = tid >> 6;
    const int gw = blockIdx.x * 8 + wave, NGW = gridDim.x * 8;
    unsigned char* ws = a.ws;
    LAS float* scr = (LAS float*)(lds + wave * 16384);
    constexpr int IT_FIN = (D / 64) * (NFF / 32), IT_FOUT = (DFFP / 64) * (D / 32), IT_WIN = (D / 64) * (DIN / 32), IT_WOUT = (D / 64) * (D / 32);
    constexpr int IT_L = 2 * IT_FIN + 2 * IT_FOUT + IT_WIN + IT_WOUT;
    for (int it = gw; it < DEPTH * IT_L; it += NGW) {
        const int l = it / IT_L; int r = it % IT_L;
        unsigned char* wl = ws + (size_t)l * WS_WL;
        if (r < 2 * IT_FIN) {
            const int f = r / IT_FIN; r %= IT_FIN; const int kb = r / (NFF / 32), nb = r % (NFF / 32);
            const int nd0 = nb * 32, pn = nd0 >> 8, bj = (nd0 >> 7) & 1, f0 = pn * 128 + (nd0 & 127);
            const float* src = a.in[f ? I_F2WI : I_F1WI] + (size_t)l * D * 2 * DFF; const float* gain = a.in[f ? I_F2N : I_F1N] + l * D;
            transpose_block(src, 2 * DFF, gain, (bf16_t*)(wl + (f ? WO_FFNIN1 : WO_FFNIN0)), D, kb * 64, nd0, bj * DFF + f0, f0 < DFF, scr, lane);
            continue;
        }
        r -= 2 * IT_FIN;
        if (r < 2 * IT_FOUT) {
            const int f = r / IT_FOUT; r %= IT_FOUT; const int kb = r / (D / 32), nb = r % (D / 32);
            const float* src = a.in[f ? I_F2WO : I_F1WO] + (size_t)l * DFF * D;
            transpose_block(src, D, nullptr, (bf16_t*)(wl + (f ? WO_FFNOUT1 : WO_FFNOUT0)), DFFP, kb * 64, nb * 32, nb * 32, kb * 64 < DFF, scr, lane);
            continue;
        }
        r -= 2 * IT_FOUT;
        if (r < IT_WIN) {
            const int kb = r / (DIN / 32), nb = r % (DIN / 32);
            transpose_block(a.in[I_WIN] + (size_t)l * D * DIN, DIN, a.in[I_MIXN] + l * D, (bf16_t*)(wl + WO_WIN), D, kb * 64, nb * 32, nb * 32, true, scr, lane);
            continue;
        }
        r -= IT_WIN;
        { const int kb = r / (D / 32), nb = r % (D / 32);
          transpose_block(a.in[I_WOUT] + (size_t)l * D * D, D, nullptr, (bf16_t*)(wl + WO_WOUT), D, kb * 64, nb * 32, nb * 32, true, scr, lane); }
    }
    const int gt = blockIdx.x * NTHREADS + tid, NGT = gridDim.x * NTHREADS;
    for (int i = gt; i < DEPTH * 8 * 64 * 64; i += NGT) {
        const int l = i >> 15, rem = i & 32767, h = rem >> 12, n = (rem >> 6) & 63, k = rem & 63;
        const size_t s = ((size_t)(l * 8 + h) * 64 + k) * 64 + n;
        bf16_t* sm = (bf16_t*)(ws + WS_SMALL + (size_t)l * SMALL_L);
        sm[SO_RGA / 2 + rem] = (bf16_t)(cvt_pk_bf16(a.in[I_RGWA][s] * -1.4426950409f, 0.f) & 0xffffu);
        sm[SO_RGX / 2 + rem] = (bf16_t)(cvt_pk_bf16(a.in[I_RGWX][s] * -1.4426950409f, 0.f) & 0xffffu);
    }
    for (int i = gt; i < DEPTH * 4 * 64 * 64; i += NGT) {
        const int l = i >> 14, rem = i & 16383, g = rem >> 12, n = (rem >> 6) & 63, k = rem & 63;
        const size_t s = ((size_t)(l * 4 + g) * 64 + k) * 64 + n;
        bf16_t* sm = (bf16_t*)(ws + WS_SMALL + (size_t)l * SMALL_L);
        sm[SO_POOL / 2 + rem] = (bf16_t)(cvt_pk_bf16(a.in[I_POOLW][s], 0.f) & 0xffffu);
    }
    for (int i = gt; i < DEPTH * 4 * 128 * 128; i += NGT) {
        const int l = i >> 16, rem = i & 65535, t = (rem >> 7) & 127, s = rem & 127;
        bf16_t* sm = (bf16_t*)(ws + WS_SMALL + (size_t)l * SMALL_L);
        const float v = (s <= t) ? a.in[I_SGUW][i] : 0.f;
        sm[SO_SGU / 2 + rem] = (bf16_t)(cvt_pk_bf16(v, 0.f) & 0xffffu);
    }
    u32s* rowss = (u32s*)(ws + WS_ROWSS);
    for (int i = gt; i < 6 * M; i += NGT) rowss[M + i] = 0u;
    bf16_t* XB = (bf16_t*)(ws + WS_XB);
    for (int m0 = gw * 4; m0 < M; m0 += NGW * 4) {
        f32x4 v[4][4];
#pragma unroll
        for (int i = 0; i < 4; ++i)
#pragma unroll
            for (int j = 0; j < 4; ++j) v[i][j] = ((const f32x4*)(a.in[I_X] + (size_t)(m0 + i) * D) + lane)[64 * j];
#pragma unroll
        for (int i = 0; i < 4; ++i) {
            u32x2* o8 = (u32x2*)(XB + (size_t)(m0 + i) * D) + lane; float ss = 0.f;
#pragma unroll
            for (int j = 0; j < 4; ++j) { const f32x4 w = v[i][j]; ss += (w.x * w.x + w.y * w.y) + (w.z * w.z + w.w * w.w); o8[64 * j] = pack4(w); }
#pragma unroll
            for (int o = 1; o < 64; o <<= 1) ss += shfl_xor_l(ss, o, lane);
            if (lane == 0) rowss[m0 + i] = (u32s)(ss * SS_SCALE);
        }
    }
}

__device__ __forceinline__ int xcd_item(int i, int n) { return (i & 7) * (n >> 3) + (i >> 3); }

__device__ __forceinline__ void load_rglru_consts(const Args& a, int l, LAS float* cst, int wave_s) {
    const int ch = fresh_tid(wave_s);
#pragma unroll
    for (int k = 0; k < 4; ++k) cst[k * 512 + ch] = a.in[I_CONVW][(l * 4 + k) * 512 + ch];
    cst[4 * 512 + ch] = a.in[I_CONVB][l * 512 + ch];
    cst[5 * 512 + ch] = a.in[I_RGBA][l * 512 + ch] * -1.4426950409f;
    cst[6 * 512 + ch] = a.in[I_RGBX][l * 512 + ch] * -1.4426950409f;
    cst[7 * 512 + ch] = -1.0f / (8.0f * log1pf(expf(-a.in[I_LAM][l * 512 + ch])) * 1.4426950409f);
    __syncthreads();
}

template <bool FINAL>
__device__ __forceinline__ void rglru_phase(const Args& a, int l, LAS unsigned char* lds, int wave_s) {
    const int tid_ = fresh_tid(wave_s);
    const int tid = tid_, lane = tid & 63, h = tid >> 6, r = lane & 15, q = lane >> 4;
    unsigned char* ws = a.ws;
    const bf16_t* P = (const bf16_t*)(ws + WS_P); bf16_t* Y = (bf16_t*)(ws + WS_Y);
    float* sumA = (float*)(ws + WS_SUMA); float* sumH = (float*)(ws + WS_SUMH);
    LAS float* cst = (LAS float*)lds;
    const int chl = 64 * h + 4 * q;
    const bf16_t* sm = (const bf16_t*)(ws + WS_SMALL + (size_t)l * SMALL_L);
    bf16x8 WaF[4][2], WxF[4][2];
#pragma unroll
    for (int nt = 0; nt < 4; ++nt)
#pragma unroll
        for (int ks = 0; ks < 2; ++ks) {
            const size_t o = ((size_t)h * 64 + 16 * nt + r) * 64 + 32 * ks + 4 * q;
            WaF[nt][ks] = mk8(*(const u32x2*)(sm + SO_RGA / 2 + o), *(const u32x2*)(sm + SO_RGA / 2 + o + 16));
            WxF[nt][ks] = mk8(*(const u32x2*)(sm + SO_RGX / 2 + o), *(const u32x2*)(sm + SO_RGX / 2 + o + 16));
        }
    for (int i0_ = blockIdx.x; i0_ < BATCH * NCH; i0_ += gridDim.x) {
        const int it = xcd_item(i0_, BATCH * NCH);
        const int b = it / NCH, c = it % NCH;
        f32x4 cH[4], cA[4];
#pragma unroll
        for (int nt = 0; nt < 4; ++nt) { cH[nt] = (f32x4){0.f, 0.f, 0.f, 0.f}; cA[nt] = (f32x4){1.f, 1.f, 1.f, 1.f}; }
        if (FINAL) {
            f32x4 H1[4];
#pragma unroll
            for (int grp = 0; grp < 2; ++grp) {
                const int cp = r + 16 * grp; const bool valid = cp < c;
                const size_t so = ((size_t)(b * NCH + (valid ? cp : 0))) * 512 + chl;
#pragma unroll
                for (int nt = 0; nt < 4; ++nt) {
                    f32x4 A = *(const f32x4*)(sumA + so + 16 * nt), H = *(const f32x4*)(sumH + so + 16 * nt);
                    if (!valid) { A = (f32x4){1.f, 1.f, 1.f, 1.f}; H = (f32x4){0.f, 0.f, 0.f, 0.f}; }
#define SCAN_STEP(SH) _Pragma("unroll") for (int j = 0; j < 4; ++j) { const float Ap = dpp_shr<SH>(1.0f, A[j]), Hp = dpp_shr<SH>(0.0f, H[j]); H[j] = A[j] * Hp + H[j]; A[j] = A[j] * Ap; }
                    SCAN_STEP(1) SCAN_STEP(2) SCAN_STEP(4) SCAN_STEP(8)
#undef SCAN_STEP
                    if (grp == 0) H1[nt] = H; else cH[nt] = A * H1[nt] + H;
                }
            }
        }
        u32x2 nx[4][4];
#define RG_ISSUE(MT) do { const int pos_ = c * TCH + 16 * (MT) + r; const size_t tok_ = (size_t)b * SEQ + pos_; \
            _Pragma("unroll") for (int k = 0; k < 4; ++k) { _Pragma("unroll") for (int nt = 0; nt < 4; ++nt) nx[k][nt] = (u32x2){0u, 0u}; \
                if (pos_ - 3 + k >= 0) { _Pragma("unroll") for (int nt = 0; nt < 4; ++nt) nx[k][nt] = *(const u32x2*)(P + (tok_ - 3 + k) * DIN + 512 + chl + 16 * nt); } } \
            } while (0)
        RG_ISSUE(0);
#pragma unroll 1
        for (int mt = 0; mt < TCH / 16; ++mt) {
            asm volatile("" ::: "memory");
            const int pos = c * TCH + 16 * mt + r; const size_t tok = (size_t)b * SEQ + pos;
            f32x4 xc[4]; u32x2 gcur[4];
#pragma unroll
            for (int nt = 0; nt < 4; ++nt) { xc[nt] = *(const LAS f32x4*)(cst + 4 * 512 + chl + 16 * nt); if (FINAL) gcur[nt] = *(const u32x2*)(P + tok * DIN + chl + 16 * nt); }
#pragma unroll
            for (int k = 0; k < 4; ++k)
#pragma unroll
                for (int nt = 0; nt < 4; ++nt) xc[nt] += *(const LAS f32x4*)(cst + k * 512 + chl + 16 * nt) * unpack4(nx[k][nt]);
            __builtin_amdgcn_sched_barrier(0);
            if (mt + 1 < TCH / 16) RG_ISSUE(mt + 1);
            __builtin_amdgcn_sched_barrier(0);
            bf16x8 Xf[2];
#pragma unroll
            for (int ks = 0; ks < 2; ++ks) Xf[ks] = mk8(pack4(xc[2 * ks]), pack4(xc[2 * ks + 1]));
#pragma unroll
            for (int nt = 0; nt < 4; ++nt) {
                const f32x4 sp = *(const LAS f32x4*)(cst + 7 * 512 + chl + 16 * nt);
                f32x4 ar = *(const LAS f32x4*)(cst + 5 * 512 + chl + 16 * nt), ai = *(const LAS f32x4*)(cst + 6 * 512 + chl + 16 * nt);
#pragma unroll
                for (int ks = 0; ks < 2; ++ks) { ar = __builtin_amdgcn_mfma_f32_16x16x32_bf16(WaF[nt][ks], Xf[ks], ar, 0, 0, 0); ai = __builtin_amdgcn_mfma_f32_16x16x32_bf16(WxF[nt][ks], Xf[ks], ai, 0, 0, 0); }
                f32x4 A, H;
#pragma unroll
                for (int j = 0; j < 4; ++j) {
                    const float ii = __builtin_amdgcn_rcpf(1.0f + __builtin_amdgcn_exp2f(ai[j]));
                    const float av = __builtin_amdgcn_exp2f(__builtin_amdgcn_rcpf(__builtin_fmaf(__builtin_amdgcn_exp2f(ar[j]), sp[j], sp[j])));
                    const float mult = __builtin_amdgcn_sqrtf(1.0f - av * av);
                    A[j] = av; H[j] = mult * (ii * xc[nt][j]);
                }
#pragma unroll
                for (int j = 0; j < 4; ++j) {
                    const float hin = (!FINAL && mt == 0) ? cH[nt][j] : dpp_ror1(cH[nt][j]);
                    const float Hn = A[j] * hin + H[j];
                    H[j] = (r == 0) ? Hn : H[j];
                    if (!FINAL) { const float ain = (mt == 0) ? cA[nt][j] : dpp_ror1(cA[nt][j]); const float An = A[j] * ain; A[j] = (r == 0) ? An : A[j]; }
                }
#define SCAN_STEP(SH) _Pragma("unroll") for (int j = 0; j < 4; ++j) { const float Ap = dpp_shr<SH>(1.0f, A[j]), Hp = dpp_shr<SH>(0.0f, H[j]); H[j] = A[j] * Hp + H[j]; A[j] = A[j] * Ap; }
                SCAN_STEP(1) SCAN_STEP(2) SCAN_STEP(4) SCAN_STEP(8)
#undef SCAN_STEP
                cH[nt] = H;
                __builtin_amdgcn_sched_barrier(0);
                if (FINAL) {
                    const f32x4 g = gelu4(unpack4(gcur[nt]));
                    *(u32x2*)(Y + tok * D + chl + 16 * nt) = pack4(g * H);
                } else {
                    cA[nt] = A;
                }
            }
        }
#undef RG_ISSUE
        if (!FINAL && r == 15) {
            const size_t so = ((size_t)(b * NCH + c)) * 512 + chl;
#pragma unroll
            for (int nt = 0; nt < 4; ++nt) { *(f32x4*)(sumA + so + 16 * nt) = cA[nt]; *(f32x4*)(sumH + so + 16 * nt) = cH[nt]; }
        }
    }
}

__device__ __forceinline__ void pool_phase(const Args& a, int l, int wave_s) {
    const int tid_ = fresh_tid(wave_s);
    const int tid = tid_, lane = tid & 63, wave = tid >> 6, r = lane & 15, q = lane >> 4, g = wave & 3, half = wave >> 2;
    unsigned char* ws = a.ws;
    const bf16_t* P = (const bf16_t*)(ws + WS_P); bf16_t* Y = (bf16_t*)(ws + WS_Y);
    const bf16_t* sm = (const bf16_t*)(ws + WS_SMALL + (size_t)l * SMALL_L) + SO_POOL / 2;
    const int chl = 64 * g + 4 * q, win = 2 << g;
    bf16x8 PF[4][2]; f32x4 sc[4];
#pragma unroll
    for (int nt = 0; nt < 4; ++nt) {
        sc[nt] = *(const f32x4*)(a.in[I_POOLS] + l * DPOOL + chl + 16 * nt);
#pragma unroll
        for (int ks = 0; ks < 2; ++ks) { const size_t o = ((size_t)g * 64 + 16 * nt + r) * 64 + 32 * ks + 4 * q; PF[nt][ks] = mk8(*(const u32x2*)(sm + o), *(const u32x2*)(sm + o + 16)); }
    }
    for (int i0_ = blockIdx.x; i0_ < M / 128; i0_ += gridDim.x) {
        const int it = xcd_item(i0_, M / 128);
        const int b = it / (SEQ / 128), pos0 = (it % (SEQ / 128)) * 128 + half * 64;
#pragma unroll 1
        for (int mt = 0; mt < 4; ++mt) {
            const int pos = pos0 + 16 * mt + r; const size_t tok = (size_t)b * SEQ + pos;
            f32x4 sum[4], x0[4], sp[4];
#pragma unroll
            for (int nt = 0; nt < 4; ++nt) { x0[nt] = unpack4(*(const u32x2*)(P + tok * DIN + 1024 + chl + 16 * nt)); sum[nt] = x0[nt]; sp[nt] = (f32x4){0.f, 0.f, 0.f, 0.f}; }
            if (pos0 + 16 * mt >= 16) {
#pragma unroll
                for (int nt = 0; nt < 4; ++nt) sp[nt] = unpack4(*(const u32x2*)(P + (tok - 16) * DIN + 1024 + chl + 16 * nt));
            }
#define POOL_STEP(K) if (win > (K)) { _Pragma("unroll") for (int nt = 0; nt < 4; ++nt) _Pragma("unroll") for (int j = 0; j < 4; ++j) { \
                const float tc = dpp_ror<K>(sum[nt][j]), tp = dpp_ror<K>(sp[nt][j]); sum[nt][j] += (r >= (K)) ? tc : tp; sp[nt][j] += tp; } }
            POOL_STEP(1) POOL_STEP(2) POOL_STEP(4) POOL_STEP(8)
#undef POOL_STEP
            const float inv = 1.0f / (float)((pos + 1 < win) ? pos + 1 : win);
            f32x4 d[4];
#pragma unroll
            for (int nt = 0; nt < 4; ++nt) d[nt] = sum[nt] * inv - x0[nt];
            bf16x8 Xf[2];
#pragma unroll
            for (int ks = 0; ks < 2; ++ks) Xf[ks] = mk8(pack4(d[2 * ks]), pack4(d[2 * ks + 1]));
#pragma unroll
            for (int nt = 0; nt < 4; ++nt) {
                f32x4 acc = (f32x4){0.f, 0.f, 0.f, 0.f};
                acc = __builtin_amdgcn_mfma_f32_16x16x32_bf16(PF[nt][0], Xf[0], acc, 0, 0, 0);
                acc = __builtin_amdgcn_mfma_f32_16x16x32_bf16(PF[nt][1], Xf[1], acc, 0, 0, 0);
                *(u32x2*)(Y + tok * D + 512 + chl + 16 * nt) = pack4(acc * sc[nt]);
            }
        }
    }
}

constexpr int VP = 136;
__device__ __forceinline__ void sgu_phase(const Args& a, int l, LAS unsigned char* lds, int wave_s) {
    const int tid_ = fresh_tid(wave_s);
    const int tid = tid_, lane = tid & 63, wave = tid >> 6, r = lane & 15, q = lane >> 4;
    unsigned char* ws = a.ws;
    const bf16_t* P = (const bf16_t*)(ws + WS_P); bf16_t* Y = (bf16_t*)(ws + WS_Y);
    const bf16_t* sw = (const bf16_t*)(ws + WS_SMALL + (size_t)l * SMALL_L) + SO_SGU / 2;
    LAS bf16_t* Vt = (LAS bf16_t*)(lds + 16384);
    for (int i0_ = blockIdx.x; i0_ < M / 128; i0_ += gridDim.x) {
        const int it = xcd_item(i0_, M / 128);
        const size_t tok0 = (size_t)it * 128;
        {
            const size_t tok = tok0 + 16 * wave + r;
            f32x4 v[16]; float ss = 0.f;
#pragma unroll
            for (int i = 0; i < 16; ++i) { v[i] = gelu4(unpack4(*(const u32x2*)(P + tok * DIN + 1536 + 16 * i + 4 * q))); ss += (v[i].x * v[i].x + v[i].y * v[i].y) + (v[i].z * v[i].z + v[i].w * v[i].w); }
            ss += shfl_xor_l(ss, 16, lane); ss += shfl_xor_l(ss, 32, lane);
            const float rstd = __builtin_amdgcn_rsqf(ss * (1.0f / DSGU) + EPS);
#pragma unroll
            for (int i = 0; i < 16; ++i) {
                const f32x4 gn = *(const f32x4*)(a.in[I_SGUN] + l * DSGU + 16 * i + 4 * q);
                const f32x4 o = v[i] * gn * rstd;
                const u32x2 w = pack4(o);
                LAS bf16_t* dst = Vt + (16 * i + 4 * q) * VP + 16 * wave + r;
                dst[0] = (bf16_t)(w.x & 0xffffu); dst[VP] = (bf16_t)(w.x >> 16); dst[2 * VP] = (bf16_t)(w.y & 0xffffu); dst[3 * VP] = (bf16_t)(w.y >> 16);
            }
        }
        __syncthreads();
        {
            const int hh = wave & 3, grp = wave >> 2;
#pragma unroll 1
            for (int mi = 0; mi < 4; ++mi) {
                const int aa = 2 * grp + (mi >> 1), mt = (mi & 1) ? 7 - aa : aa, nks = (mt >> 1) + 1;
                f32x4 acc[4];
#pragma unroll
                for (int nt = 0; nt < 4; ++nt) acc[nt] = (f32x4){0.f, 0.f, 0.f, 0.f};
                const bf16_t* Wrow = sw + ((size_t)hh * 128 + 16 * mt + r) * 128 + 8 * q;
                const size_t tok = tok0 + 16 * mt + r;
                bf16x8 Wf[4]; u32x2 uw[4];
#pragma unroll
                for (int ks = 0; ks < 4; ++ks) Wf[ks] = *(const bf16x8*)(Wrow + 32 * (ks < nks ? ks : 0));
#pragma unroll
                for (int nt = 0; nt < 4; ++nt) uw[nt] = *(const u32x2*)(P + tok * DIN + 1280 + 64 * hh + 16 * nt + 4 * q);
                const float bias = a.in[I_SGUB][(l * 4 + hh) * 128 + 16 * mt + r];
#pragma unroll
                for (int ks = 0; ks < 4; ++ks) {
                    if (ks < nks) {
#pragma unroll
                        for (int nt = 0; nt < 4; ++nt) {
                            const bf16x8 Vf = *(const LAS bf16x8*)(Vt + (64 * hh + 16 * nt + r) * VP + 32 * ks + 8 * q);
                            acc[nt] = __builtin_amdgcn_mfma_f32_16x16x32_bf16(Vf, Wf[ks], acc[nt], 0, 0, 0);
                        }
                    }
                }
#pragma unroll
                for (int nt = 0; nt < 4; ++nt) {
                    const f32x4 uu = gelu4(unpack4(uw[nt]));
                    *(u32x2*)(Y + tok * D + 768 + 64 * hh + 16 * nt + 4 * q) = pack4(uu * (acc[nt] + bias));
                }
            }
        }
        __syncthreads();
    }
}

__device__ __forceinline__ void final_norm(const Args& a, int wave_s) {
    const int tid_ = fresh_tid(wave_s);
    const int tid = tid_, lane = tid & 63, wave = tid >> 6;
    const int gw = blockIdx.x * 8 + wave, NGW = gridDim.x * 8;
    const u32s* rowss = (const u32s*)(a.ws + WS_ROWSS) + (size_t)6 * M;
    f32x4 fn[4];
#pragma unroll
    for (int j = 0; j < 4; ++j) fn[j] = *((const f32x4*)a.in[I_FINN] + lane + 64 * j);
    const bf16_t* XB = (const bf16_t*)(a.ws + WS_XB);
    for (int m0 = gw * 4; m0 < M; m0 += NGW * 4) {
        u32x2 xi[4][4]; float rstd[4];
#pragma unroll
        for (int i = 0; i < 4; ++i) {
            rstd[i] = __builtin_amdgcn_rsqf((float)rowss[m0 + i] * (SS_INV / D) + EPS);
#pragma unroll
            for (int j = 0; j < 4; ++j) xi[i][j] = ((const u32x2*)(XB + (size_t)(m0 + i) * D) + lane)[64 * j];
        }
#pragma unroll
        for (int i = 0; i < 4; ++i) {
            f32x4* o = (f32x4*)(a.out + (size_t)(m0 + i) * D) + lane;
#pragma unroll
            for (int j = 0; j < 4; ++j) o[64 * j] = unpack4(xi[i][j]) * rstd[i] * fn[j];
        }
    }
}

#ifdef DBL_SYNC
#define GSYNC() do { xcd_barrier(xbar); xcd_barrier(xbar); } while (0)
#else
#define GSYNC() xcd_barrier(xbar)
#endif
#ifndef PEEL_G1
#define PEEL_G1 true
#endif
#ifndef PEEL_G2
#define PEEL_G2 true
#endif
#ifndef PEEL_G3
#define PEEL_G3 true
#endif
#ifndef PEEL_G4
#define PEEL_G4 true
#endif
__global__ void __launch_bounds__(NTHREADS, 2) mega_fwd(Args a) {
    extern __shared__ __attribute__((aligned(16))) unsigned char lds_raw[];
    LAS unsigned char* lds = (LAS unsigned char*)lds_raw;
    cg::grid_group grid = cg::this_grid();
    unsigned char* ws = a.ws;
    bf16_t* XB = (bf16_t*)(ws + WS_XB); bf16_t* ACT = (bf16_t*)(ws + WS_ACT); bf16_t* PB = (bf16_t*)(ws + WS_P); bf16_t* YB = (bf16_t*)(ws + WS_Y);
    u32s* rowss = (u32s*)(ws + WS_ROWSS);
    const int G = gridDim.x, bid = blockIdx.x;

    const int wave_s = __builtin_amdgcn_readfirstlane((int)(threadIdx.x >> 6));
    { volatile LAS unsigned* st = (volatile LAS unsigned*)(lds + 131072); if (threadIdx.x < 16) st[threadIdx.x] = 0u; }
    __syncthreads();
    const XcdBarrier xbar = xcd_barrier_post((unsigned*)(ws + WS_CTL), (volatile LAS unsigned*)(lds + 131072), wave_s);
    prologue(a, lds, wave_s);
#ifdef DBL_PRO
    prologue(a, lds, wave_s);
#endif
    if (a.ws == nullptr) grid.sync();
    xcd_barrier(xbar);

    int nrm = 0;
#pragma unroll 1
    for (int l = 0; l < DEPTH; ++l) {
        const unsigned char* wl = ws + (size_t)l * WS_WL;
#pragma unroll 1
        for (int f = 0; f < 2; ++f) {
            {
                pg8::Gemm g{XB, (const bf16_t*)(wl + (f ? WO_FFNIN1 : WO_FFNIN0)), M, NFF, D}; pg8::StaticOrder S; S.init(M, NFF, G, bid);
                pg8::EpiSwiGLU E{ACT, rowss + (size_t)nrm * M};
                pg8::gemm_phase<pg8::EpiSwiGLU, false, PEEL_G1, NFF / 256>(lds, g, S, E, wave_s);
#ifdef DBL_G1
                pg8::gemm_phase(lds, g, S, E, wave_s);
#endif
            }
            GSYNC();
            {
                pg8::Gemm g{ACT, (const bf16_t*)(wl + (f ? WO_FFNOUT1 : WO_FFNOUT0)), M, D, DFFP}; pg8::StaticOrder S; S.init(M, D, G, bid);
                pg8::EpiResid E{XB, rowss + (size_t)(nrm + 1) * M, 0.5f};
                pg8::gemm_phase<pg8::EpiResid, true, PEEL_G2, D / 256>(lds, g, S, E, wave_s);
            }
            ++nrm;
            GSYNC();
            if (f == 0) {
                {
                    pg8::Gemm g{XB, (const bf16_t*)(wl + WO_WIN), M, DIN, D}; pg8::StaticOrder S; S.init(M, DIN, G, bid);
                    pg8::EpiP E{PB, rowss + (size_t)nrm * M};
                    pg8::gemm_phase<pg8::EpiP, false, PEEL_G3, DIN / 256>(lds, g, S, E, wave_s);
#ifdef DBL_G3
                    pg8::gemm_phase(lds, g, S, E, wave_s);
#endif
                }
                GSYNC();
                load_rglru_consts(a, l, (LAS float*)lds, wave_s);
                rglru_phase<false>(a, l, lds, wave_s);
#ifdef DBL_M1A
                rglru_phase<false>(a, l, lds, wave_s);
#endif
                pool_phase(a, l, wave_s);
#ifdef DBL_POOL
                pool_phase(a, l, wave_s);
#endif
                sgu_phase(a, l, lds, wave_s);
#ifdef DBL_SGU
                sgu_phase(a, l, lds, wave_s);
#endif
                GSYNC();
                rglru_phase<true>(a, l, lds, wave_s);
#ifdef DBL_M2
                rglru_phase<true>(a, l, lds, wave_s);
#endif
                GSYNC();
                {
                    pg8::Gemm g{YB, (const bf16_t*)(wl + WO_WOUT), M, D, D}; pg8::StaticOrder S; S.init(M, D, G, bid);
                    pg8::EpiResid E{XB, rowss + (size_t)(nrm + 1) * M, 1.0f};
                    pg8::gemm_phase<pg8::EpiResid, false, PEEL_G4, D / 256>(lds, g, S, E, wave_s);
                }
                ++nrm;
                GSYNC();
            }
        }
    }
    final_norm(a, wave_s);
}

extern "C" void kernel_launch(void* const* d_in, const int* in_sizes, int n_in, void* d_out, int out_size, void* d_ws, size_t ws_size, hipStream_t stream) {
    static int grid = 0;
    if (grid == 0) {
        if (n_in != 23 || in_sizes[0] != M * D || out_size != M * D || ws_size < WS_END) { fprintf(stderr, "kernel_launch: unexpected shapes (n_in %d, in0 %d, out %d, ws %zu)\n", n_in, n_in > 0 ? in_sizes[0] : -1, out_size, ws_size); grid = -1; return; }
        int dev = 0, cus = 0, per_cu = 0;
        hipGetDevice(&dev); hipDeviceGetAttribute(&cus, hipDeviceAttributeMultiprocessorCount, dev);
        if (hipFuncSetAttribute((const void*)mega_fwd, hipFuncAttributeMaxDynamicSharedMemorySize, LDS_BYTES) != hipSuccess) { fprintf(stderr, "kernel_launch: hipFuncSetAttribute failed\n"); }
        if (hipOccupancyMaxActiveBlocksPerMultiprocessor(&per_cu, (const void*)mega_fwd, NTHREADS, LDS_BYTES) != hipSuccess || per_cu < 1) { fprintf(stderr, "kernel_launch: occupancy query says %d\n", per_cu); per_cu = 1; }
        (void)hipGetLastError();
        grid = cus * 1;
        if (grid <= 0) grid = 256;
    }
    if (grid < 0) return;
    Args a{};
    for (int i = 0; i < 23; ++i) a.in[i] = (const float*)d_in[i];
    a.out = (float*)d_out; a.ws = (unsigned char*)d_ws;
    if (hipMemsetAsync((char*)d_ws + WS_CTL, 0, CTL_BYTES, stream) != hipSuccess) { fprintf(stderr, "kernel_launch: memset failed\n"); return; }
    void* args[] = {&a};
    hipError_t e = hipLaunchCooperativeKernel((const void*)mega_fwd, dim3(grid), dim3(NTHREADS), args, LDS_BYTES, stream);
    if (e != hipSuccess) fprintf(stderr, "kernel_launch: cooperative launch failed: %s (grid %d)\n", hipGetErrorString(e), grid);
}
```

```cpp
#include <hip/hip_runtime.h>
#include <hip/hip_cooperative_groups.h>
#include <cstdio>
namespace cg = cooperative_groups;

#define LAS __attribute__((address_space(3)))
typedef unsigned short bf16_t;
typedef short bf16x8 __attribute__((ext_vector_type(8)));
typedef float f32x4 __attribute__((ext_vector_type(4)));
typedef unsigned u32x4 __attribute__((ext_vector_type(4)));
typedef unsigned u32x2 __attribute__((ext_vector_type(2)));
typedef unsigned u32s;
constexpr float SS_SCALE = 16384.0f, SS_INV = 1.0f / 16384.0f;

constexpr int D = 1024, BATCH = 8, SEQ = 8192, M = BATCH * SEQ, DEPTH = 2;
constexpr int DRNN = 512, DPOOL = 256, DSGU = 256, DIN = 1792, DFF = 2752, DFFP = 2816, NFF = 2 * DFFP;
constexpr int TCH = 256, NCH = SEQ / TCH;
constexpr float EPS = 1e-6f;
constexpr int NTHREADS = 512;
constexpr int LDS_RS = 131072 + 64;
constexpr int LDS_BYTES = 131072 + 64 + 1024;

constexpr size_t MiB = 1u << 20;
constexpr size_t WS_WL = 40 * MiB;
constexpr size_t WO_FFNIN0 = 0, WO_FFNOUT0 = 11 * MiB, WO_FFNIN1 = 17 * MiB, WO_FFNOUT1 = 28 * MiB, WO_WIN = 34 * MiB, WO_WOUT = 38 * MiB;
constexpr size_t WS_SMALL = 80 * MiB, SMALL_L = 512 * 1024;
constexpr size_t SO_RGA = 0, SO_RGX = 65536, SO_POOL = 131072, SO_SGU = 163840;
constexpr size_t WS_ROWSS = 81 * MiB;
constexpr size_t WS_SUMA = 85 * MiB, WS_SUMH = 85 * MiB + 512 * 1024;
constexpr size_t WS_XB = 86 * MiB;
constexpr size_t WS_ACT = 214 * MiB;
constexpr size_t WS_P = WS_ACT, WS_Y = WS_ACT + 224 * MiB;
constexpr size_t WS_END = 566 * MiB;
constexpr size_t WS_CTL = 84 * MiB + 768 * 1024, CTL_BYTES = 16384;

__device__ __forceinline__ unsigned cvt_pk_bf16(float lo, float hi) { unsigned r; asm("v_cvt_pk_bf16_f32 %0, %1, %2" : "=v"(r) : "v"(lo), "v"(hi)); return r; }
__device__ __forceinline__ f32x4 unpack4(u32x2 w) { f32x4 v; v.x = __uint_as_float(w.x << 16); v.y = __uint_as_float(w.x & 0xffff0000u); v.z = __uint_as_float(w.y << 16); v.w = __uint_as_float(w.y & 0xffff0000u); return v; }
__device__ __forceinline__ u32x2 pack4(f32x4 v) { u32x2 w; w.x = cvt_pk_bf16(v.x, v.y); w.y = cvt_pk_bf16(v.z, v.w); return w; }
__device__ __forceinline__ float sigmoidf_(float z) { return __builtin_amdgcn_rcpf(1.0f + __expf(-z)); }
__device__ __forceinline__ float gelu_t(float x) { const float w = __builtin_fmaf(x * x, -0.1029432395f, -2.3022082003f); return x * __builtin_amdgcn_rcpf(1.0f + __builtin_amdgcn_exp2f(x * w)); }
__device__ __forceinline__ f32x4 gelu4(f32x4 v) { f32x4 o; o.x = gelu_t(v.x); o.y = gelu_t(v.y); o.z = gelu_t(v.z); o.w = gelu_t(v.w); return o; }
__device__ __forceinline__ bf16x8 mk8(u32x2 lo, u32x2 hi) { u32x4 v; v.x = lo.x; v.y = lo.y; v.z = hi.x; v.w = hi.y; return __builtin_bit_cast(bf16x8, v); }
__device__ __forceinline__ int fresh_lane() { int lane; asm volatile("v_mbcnt_lo_u32_b32 %0, -1, 0\n\tv_mbcnt_hi_u32_b32 %0, -1, %0" : "=v"(lane)); return lane; }
__device__ __forceinline__ int fresh_tid(int wave_s) { return wave_s * 64 + fresh_lane(); }
__device__ __forceinline__ float shfl_xor_l(float v, int mask, int lane) { return __builtin_bit_cast(float, __builtin_amdgcn_ds_bpermute((lane ^ mask) << 2, __builtin_bit_cast(int, v))); }
template <int SH> __device__ __forceinline__ float dpp_shr(float old, float v) {
    return __builtin_bit_cast(float, __builtin_amdgcn_update_dpp(__builtin_bit_cast(int, old), __builtin_bit_cast(int, v), 0x110 + SH, 0xf, 0xf, false));
}

template <int K> __device__ __forceinline__ float dpp_ror(float v) {
    return __builtin_bit_cast(float, __builtin_amdgcn_update_dpp(0, __builtin_bit_cast(int, v), 0x120 + K, 0xf, 0xf, false));
}
__device__ __forceinline__ float dpp_ror1(float v) {
    return __builtin_bit_cast(float, __builtin_amdgcn_update_dpp(0, __builtin_bit_cast(int, v), 0x121, 0xf, 0xf, false));
}

#ifndef RESID_DEPTH
#define RESID_DEPTH 8
#endif
namespace pg8 {
constexpr int BM = 256, BK = 64, HALF = 128, HTB = HALF * BK * 2, STAGE_BYTES = 8 * HTB, NXCD = 8, WGM = 8;
__host__ __device__ __forceinline__ int lds_byte(int r, int c) { const int st = (r >> 4) * 2 + (c >> 5), rr = r & 15, cc = c & 31, ob = rr * 64 + cc * 2; return st * 1024 + (ob ^ (((ob >> 9) & 1) << 5)); }
__host__ __device__ __forceinline__ void stage_rc(int b, int& R, int& C) { const int st = b / 1024, sb = b % 1024, swz = sb ^ (((sb >> 9) & 1) << 5); R = (st >> 1) * 16 + swz / 64; C = (st & 1) * 32 + (swz % 64) / 2; }
__host__ __device__ __forceinline__ int perm32(int rho) { const int n = rho >> 4, i = rho & 15; return 8 * (i >> 2) + 4 * n + (i & 3); }
struct Unit { int pm, pn; };
struct Gemm { const bf16_t* A; const bf16_t* Bt; int M, N, K; };
struct StaticOrder {
    int nM, nN, nwg, G, c;
    __device__ void init(int M_, int N_, int G_, int c_) { nM = M_ / BM; nN = N_ / BM; nwg = nM * nN; G = G_; c = c_; }
    __device__ bool next(int i, Unit& u) const {
        const long L = (long)i * G + c; if (L >= nwg) return false;
        int wgid = (int)L; { const int q = nwg / NXCD, r = nwg % NXCD, xcd = wgid % NXCD, off = wgid / NXCD; wgid = (xcd < r ? xcd * (q + 1) : r * (q + 1) + (xcd - r) * q) + off; }
        const int nig = WGM * nN, gid = wgid / nig, fm = gid * WGM, gsz = (nM - fm) < WGM ? (nM - fm) : WGM;
        u.pm = fm + ((wgid % nig) % gsz); u.pn = (wgid % nig) / gsz; return true;
    }
    template <int NN> __device__ __forceinline__ bool next_c(int i, Unit& u) const {
        const int L = i * G + c; if (L >= nwg) return false;
        const int wgid = (L & 7) * (nwg >> 3) + (L >> 3);
        constexpr int nig = WGM * NN; const int gid = wgid / nig, rem = wgid - gid * nig;
        u.pm = gid * WGM + (rem & (WGM - 1)); u.pn = rem / WGM; return true;
    }
};

template <class Epi, bool ABLK = false, bool PEEL = true, int NN = 0>
__device__ __forceinline__ void gemm_phase(LAS unsigned char* lds, const Gemm g, const StaticOrder& S, const Epi& E, int wave_s) {
    const int tid_ = fresh_tid(wave_s);
    const int tid = tid_, wid = __builtin_amdgcn_readfirstlane(tid >> 6), lane = tid & 63, wr = wid >> 2, wc = wid & 3, fr = lane & 15, fq = lane >> 4;
    const int K = g.K, nt = K / BK;
    unsigned voffA[2], voffB[2];
#pragma unroll
    for (int i = 0; i < 2; ++i) { int R, C; stage_rc(tid * 16 + i * 8192, R, C); const int Rb = Epi::PERM ? ((R & ~31) + perm32(R & 31)) : R;
        voffA[i] = ABLK ? (unsigned)(R * BK + C) * 2u : (unsigned)(R * K + C) * 2u; voffB[i] = (unsigned)(Rb * K + C) * 2u; }
    const size_t kstep = (size_t)(BK * 2);
    const size_t hstep = (size_t)HALF * K * 2;
    const size_t tstep = 2 * hstep;
    const size_t kstepA = ABLK ? (size_t)(BM * BK * 2) : kstep, hstepA = ABLK ? (size_t)(HALF * BK * 2) : hstep;
    const unsigned ldsw = (unsigned)wid * 1024u;
    const int aoff = lds_byte(wr * 64 + fr, fq * 8), boff = lds_byte(wc * 32 + fr, fq * 8);
#define PG8_SA(b, h) (((b) * 2 + (h)) * HTB)
#define PG8_SB(b, h) ((4 + (b) * 2 + (h)) * HTB)
#define PG8_STAGE(bufoff, gbase, voff) do { _Pragma("unroll") for (int _i = 0; _i < 2; ++_i) \
        __builtin_amdgcn_global_load_lds((const unsigned*)((const char*)(gbase) + (voff)[_i]), (LAS unsigned*)(lds + (bufoff) + ldsw + _i * 8192), 16, 0, 0); } while (0)
#define PG8_LDA(dst, b, h) do { _Pragma("unroll") for (int m = 0; m < 4; ++m) _Pragma("unroll") for (int k = 0; k < 2; ++k) dst[m][k] = *(const LAS bf16x8*)(lds + PG8_SA(b, h) + aoff + m * 2048 + k * 1024); } while (0)
#define PG8_LDB(dst, b, h) do { _Pragma("unroll") for (int n = 0; n < 2; ++n) _Pragma("unroll") for (int k = 0; k < 2; ++k) dst[n][k] = *(const LAS bf16x8*)(lds + PG8_SB(b, h) + boff + n * 2048 + k * 1024); } while (0)
#define PG8_MMA(ai, bj, At, Bt, ZC) do { __builtin_amdgcn_s_setprio(1); _Pragma("unroll") for (int m = 0; m < 4; ++m) _Pragma("unroll") for (int n = 0; n < 2; ++n) _Pragma("unroll") for (int k = 0; k < 2; ++k) \
        acc[ai][bj][m][n] = __builtin_amdgcn_mfma_f32_16x16x32_bf16(Bt[n][k], At[m][k], ((ZC) && k == 0) ? (f32x4){0.f, 0.f, 0.f, 0.f} : acc[ai][bj][m][n], 0, 0, 0); __builtin_amdgcn_s_setprio(0); } while (0)
#define PG8_WAIT_V(n) asm volatile("s_waitcnt vmcnt(" #n ")" ::: "memory")
#define PG8_WAIT_L(n) asm volatile("s_waitcnt lgkmcnt(" #n ")" ::: "memory")
#define PG8_BAR __builtin_amdgcn_s_barrier()
#define PG8_SCHED __builtin_amdgcn_sched_barrier(0)
#define PG8_BODY(FK) do { \
            const char* a1 = cA + (size_t)(t + 1) * kstepA; \
            const char* a2 = last ? nA : cA + (size_t)(t + 2) * kstepA; const char* b2 = last ? nB : cB + (size_t)(t + 2) * kstep; \
            const char* a3 = a2 + kstepA; const char* b3 = b2 + kstep; \
            if (last) E.stage(lds, cur, wid, fresh_lane()); \
            PG8_LDB(B0, 0, 0); PG8_SCHED; PG8_LDA(At, 0, 0); PG8_STAGE(PG8_SA(1, 1), a1 + hstepA, voffA); \
            PG8_WAIT_L(8); PG8_BAR; PG8_WAIT_L(0); PG8_MMA(0, 0, At, B0, FK); PG8_BAR; PG8_SCHED; \
            PG8_LDB(B1, 0, 1); PG8_STAGE(PG8_SB(0, 0), b2, voffB); \
            PG8_BAR; PG8_WAIT_L(0); PG8_MMA(0, 1, At, B1, FK); PG8_BAR; \
            PG8_LDA(At, 0, 1); PG8_STAGE(PG8_SA(0, 0), a2, voffA); \
            PG8_BAR; PG8_WAIT_L(0); PG8_MMA(1, 0, At, B0, FK); PG8_BAR; PG8_SCHED; \
            PG8_STAGE(PG8_SB(0, 1), b2 + hstep, voffB); \
            PG8_WAIT_V(6); PG8_BAR; PG8_MMA(1, 1, At, B1, FK); PG8_BAR; \
            PG8_LDB(B0, 1, 0); PG8_SCHED; PG8_LDA(At, 1, 0); PG8_STAGE(PG8_SA(0, 1), a2 + hstepA, voffA); \
            PG8_WAIT_L(8); PG8_BAR; PG8_WAIT_L(0); PG8_MMA(0, 0, At, B0, false); PG8_BAR; PG8_SCHED; \
            PG8_LDB(B1, 1, 1); PG8_STAGE(PG8_SB(1, 0), b3, voffB); \
            PG8_BAR; PG8_WAIT_L(0); PG8_MMA(0, 1, At, B1, false); PG8_BAR; \
            PG8_LDA(At, 1, 1); PG8_STAGE(PG8_SA(1, 0), a3, voffA); \
            PG8_BAR; PG8_WAIT_L(0); PG8_MMA(1, 0, At, B0, false); PG8_BAR; PG8_SCHED; \
            PG8_STAGE(PG8_SB(1, 1), b3 + hstep, voffB); \
            PG8_WAIT_V(6); PG8_BAR; PG8_MMA(1, 1, At, B1, false); PG8_BAR; \
        } while (0)
    Unit cur, nxt; int ui = 0;
    if (!(NN ? S.template next_c<(NN ? NN : 1)>(0, cur) : S.next(0, cur))) return;
    f32x4 acc[2][2][4][2];
    bf16x8 At[4][2], B0[2][2], B1[2][2];
    const char* cA = (const char*)g.A + (size_t)cur.pm * tstep; const char* cB = (const char*)g.Bt + (size_t)cur.pn * tstep;
    PG8_STAGE(PG8_SB(0, 0), cB, voffB); PG8_STAGE(PG8_SA(0, 0), cA, voffA); PG8_STAGE(PG8_SB(0, 1), cB + hstep, voffB); PG8_STAGE(PG8_SA(0, 1), cA + hstepA, voffA);
    if (wr == 1) PG8_BAR;
    PG8_WAIT_V(4); PG8_BAR;
    PG8_STAGE(PG8_SB(1, 0), cB + kstep, voffB); PG8_STAGE(PG8_SA(1, 0), cA + kstepA, voffA); PG8_STAGE(PG8_SB(1, 1), cB + hstep + kstep, voffB);
    PG8_WAIT_V(6); PG8_BAR;
    for (;;) {
        const bool has_next = NN ? S.template next_c<(NN ? NN : 1)>(ui + 1, nxt) : S.next(ui + 1, nxt);
        const char* nA = has_next ? (const char*)g.A + (size_t)nxt.pm * tstep : cA; const char* nB = has_next ? (const char*)g.Bt + (size_t)nxt.pn * tstep : cB;
        if constexpr (PEEL) {
            PG8_SCHED;
            { const int t = 0; const bool last = false; PG8_BODY(true); }
            for (int t = 2; t < nt; t += 2) { const bool last = (t == nt - 2); PG8_BODY(false); }
        } else {
            if (ui > 0 || true) {
#pragma unroll
                for (int a_ = 0; a_ < 2; ++a_)
#pragma unroll
                    for (int b_ = 0; b_ < 2; ++b_)
#pragma unroll
                        for (int m_ = 0; m_ < 4; ++m_)
#pragma unroll
                            for (int n_ = 0; n_ < 2; ++n_) acc[a_][b_][m_][n_] = (f32x4){0.f, 0.f, 0.f, 0.f};
            }
            for (int t = 0; t < nt; t += 2) { const bool last = (t == nt - 2); PG8_BODY(false); }
        }
        PG8_SCHED;
        { const int l2_ = fresh_lane(); E(acc, cur, wr, wc, l2_ & 15, l2_ >> 4, lds); }
        PG8_SCHED;
        if (!has_next) break;
        cur = nxt; cA = nA; cB = nB; ++ui;
    }
    PG8_WAIT_V(0);
    if (wr == 0) PG8_BAR;
    PG8_BAR;
#undef PG8_BODY
#undef PG8_SA
#undef PG8_SB
#undef PG8_STAGE
#undef PG8_LDA
#undef PG8_LDB
#undef PG8_MMA
#undef PG8_WAIT_V
#undef PG8_WAIT_L
#undef PG8_BAR
#undef PG8_SCHED
}

struct EpiSwiGLU {
    static constexpr bool PERM = true, IDEMPOTENT = true;
    bf16_t* O; const u32s* rowss;
    __device__ __forceinline__ void stage(LAS unsigned char* lds, const Unit& u, int wid, int lane) const {
        if (wid < 4) __builtin_amdgcn_global_load_lds((const unsigned*)(rowss + u.pm * BM + wid * 64 + lane), (LAS unsigned*)(lds + LDS_RS + wid * 256), 4, 0, 0);
    }
    __device__ __forceinline__ void operator()(const f32x4 (&acc)[2][2][4][2], const Unit& u, int wr, int wc, int fr, int fq, LAS unsigned char* lds) const {
        const int row0 = u.pm * BM + wr * 64 + fr, col0 = u.pn * HALF + wc * 32 + 8 * fq;
        u32s rs[2][4];
#pragma unroll
        for (int ai = 0; ai < 2; ++ai)
#pragma unroll
            for (int m = 0; m < 4; ++m) rs[ai][m] = ((const LAS u32s*)(lds + LDS_RS))[wr * 64 + ai * HALF + m * 16 + fr];
#pragma unroll
        for (int ai = 0; ai < 2; ++ai)
#pragma unroll
            for (int m = 0; m < 4; ++m) {
                const int row = row0 + ai * HALF + m * 16;
                const float kk = (float)rs[ai][m] * (SS_INV / D) + EPS;
                const float rstd = __builtin_amdgcn_rsqf(kk);
                u32x4 w; unsigned* wp = (unsigned*)&w;
                const float c1 = -1.4426950409f * rstd;
#pragma unroll
                for (int n = 0; n < 2; ++n) {
                    const f32x4 ag = acc[ai][0][m][n], au = acc[ai][1][m][n]; const f32x4 t = ag * c1, p = ag * au; f32x4 o;
#pragma unroll
                    for (int e = 0; e < 4; ++e) o[e] = p[e] * __builtin_amdgcn_rcpf(__builtin_fmaf(__builtin_amdgcn_exp2f(t[e]), kk, kk));
                    wp[2 * n] = cvt_pk_bf16(o[0], o[1]); wp[2 * n + 1] = cvt_pk_bf16(o[2], o[3]);
                }
                *(u32x4*)(O + ((((size_t)u.pm * (DFFP / BK) + (col0 >> 6)) * BM + (row & (BM - 1))) * BK + (col0 & (BK - 1)))) = w;
            }
    }
};
struct EpiResid {
    static constexpr bool PERM = true, IDEMPOTENT = false;
    bf16_t* xb; u32s* rowss_out; float alpha;
    __device__ __forceinline__ void stage(LAS unsigned char*, const Unit&, int, int) const {}
    __device__ __forceinline__ void operator()(const f32x4 (&acc)[2][2][4][2], const Unit& u, int wr, int wc, int fr, int fq, LAS unsigned char*) const {
        const int row0 = u.pm * BM + wr * 64 + fr, col0 = u.pn * BM + wc * 32 + 8 * fq;
        u32x4 ring[RESID_DEPTH][2];
#pragma unroll
        for (int g = 0; g < RESID_DEPTH; ++g) { const int rown = row0 + (g >> 2) * HALF + (g & 3) * 16;
#pragma unroll
            for (int bj = 0; bj < 2; ++bj) ring[g][bj] = *(const u32x4*)(xb + (size_t)rown * D + col0 + bj * HALF); }
#pragma unroll
        for (int g = 0; g < 8; ++g) {
            const int ai = g >> 2, m = g & 3;
            const int row = row0 + ai * HALF + m * 16; const size_t off = (size_t)row * D + col0; float ss = 0.f;
            u32x4 bw[2];
#pragma unroll
            for (int bj = 0; bj < 2; ++bj) bw[bj] = ring[g % RESID_DEPTH][bj];
            if (g + RESID_DEPTH < 8) { const int rown = row0 + ((g + RESID_DEPTH) >> 2) * HALF + ((g + RESID_DEPTH) & 3) * 16;
#pragma unroll
                for (int bj = 0; bj < 2; ++bj) ring[g % RESID_DEPTH][bj] = *(const u32x4*)(xb + (size_t)rown * D + col0 + bj * HALF); }
#pragma unroll
            for (int bj = 0; bj < 2; ++bj) {
                const f32x4 o0 = unpack4((u32x2){bw[bj].x, bw[bj].y}) + alpha * acc[ai][bj][m][0];
                const f32x4 o1 = unpack4((u32x2){bw[bj].z, bw[bj].w}) + alpha * acc[ai][bj][m][1];
                const u32x2 p0 = pack4(o0), p1 = pack4(o1);
                *(u32x4*)(xb + off + bj * HALF) = (u32x4){p0.x, p0.y, p1.x, p1.y};
                ss += ((o0[0] * o0[0] + o0[1] * o0[1]) + (o0[2] * o0[2] + o0[3] * o0[3])) + ((o1[0] * o1[0] + o1[1] * o1[1]) + (o1[2] * o1[2] + o1[3] * o1[3]));
            }
            { const int ln_ = fq * 16 + fr; ss += shfl_xor_l(ss, 16, ln_); ss += shfl_xor_l(ss, 32, ln_); }
            if (fq == 0) atomicAdd(rowss_out + row, (u32s)(ss * SS_SCALE));
        }
    }
};
struct EpiP {
    static constexpr bool PERM = true, IDEMPOTENT = false;
    bf16_t* O; const u32s* rowss;
    __device__ __forceinline__ void stage(LAS unsigned char* lds, const Unit& u, int wid, int lane) const {
        if (wid < 4) __builtin_amdgcn_global_load_lds((const unsigned*)(rowss + u.pm * BM + wid * 64 + lane), (LAS unsigned*)(lds + LDS_RS + wid * 256), 4, 0, 0);
    }
    __device__ __forceinline__ void operator()(const f32x4 (&acc)[2][2][4][2], const Unit& u, int wr, int wc, int fr, int fq, LAS unsigned char* lds) const {
        const int row0 = u.pm * BM + wr * 64 + fr, col0 = u.pn * BM + wc * 32 + 8 * fq;
        u32s rs[2][4];
#pragma unroll
        for (int ai = 0; ai < 2; ++ai)
#pragma unroll
            for (int m = 0; m < 4; ++m) rs[ai][m] = ((const LAS u32s*)(lds + LDS_RS))[wr * 64 + ai * HALF + m * 16 + fr];
#pragma unroll
        for (int ai = 0; ai < 2; ++ai)
#pragma unroll
            for (int m = 0; m < 4; ++m) {
                const int row = row0 + ai * HALF + m * 16;
                const float rstd = __builtin_amdgcn_rsqf((float)rs[ai][m] * (SS_INV / D) + EPS);
#pragma unroll
                for (int bj = 0; bj < 2; ++bj) {
                    const f32x4 v0 = acc[ai][bj][m][0] * rstd, v1 = acc[ai][bj][m][1] * rstd;
                    u32x4 w; w.x = cvt_pk_bf16(v0[0], v0[1]); w.y = cvt_pk_bf16(v0[2], v0[3]); w.z = cvt_pk_bf16(v1[0], v1[1]); w.w = cvt_pk_bf16(v1[2], v1[3]);
                    *(u32x4*)(O + (size_t)row * DIN + col0 + bj * HALF) = w;
                }
            }
    }
};
}

#define RLX_AGENT __ATOMIC_RELAXED, __HIP_MEMORY_SCOPE_AGENT
#define XB_TMO      128
#define XB_XCNT(j)  (256  + 64 * (j))
#define XB_XSUB(j)  (1280 + 64 * (j))
#define XB_XGEN(j)  (2304 + 64 * (j))
#define XB_TOP      3328
#define XB_TOPGEN   3392
#define XCD_BAR_WORDS 3456
#define XB_SPIN_CAP (1u << 18)

__device__ __forceinline__ unsigned xb_ld(unsigned* p)              { return __hip_atomic_load(p, __ATOMIC_RELAXED, __HIP_MEMORY_SCOPE_AGENT); }
__device__ __forceinline__ unsigned xb_add(unsigned* p, unsigned v) { return __hip_atomic_fetch_add(p, v, __ATOMIC_RELAXED, __HIP_MEMORY_SCOPE_AGENT); }
__device__ __forceinline__ unsigned xb_xcc_id() { return (unsigned)__builtin_amdgcn_s_getreg((3 << 11) | 20) & 0xFu; }
#define XB_SPIN(cond, bar) do { unsigned _sp = 0; while (cond) { __builtin_amdgcn_s_sleep(1); \
    if ((++_sp & 255u) == 0u) { if (xb_ld(&(bar)[XB_TMO])) break; if (_sp > XB_SPIN_CAP) { atomicAdd(&(bar)[XB_TMO], 1u); break; } } } } while (0)

struct XcdBarrier {
    unsigned* bar; unsigned x; int wave;
    volatile LAS unsigned* st;
};

__device__ __forceinline__ XcdBarrier xcd_barrier_post(unsigned* bar, volatile LAS unsigned* st, int wave_s) {
    XcdBarrier b; b.bar = bar; b.x = xb_xcc_id(); b.st = st; b.wave = wave_s;
    if (wave_s == 0 && fresh_lane() == 0) (void)xb_add(&bar[XB_XCNT(b.x)], 1u);
    return b;
}
__device__ __forceinline__ void xcd_barrier_complete(unsigned* bar, unsigned x, unsigned& nloc, unsigned& nx) {
    const unsigned G = gridDim.x * gridDim.y * gridDim.z;
    unsigned sum, cnt, mine, sp = 0u;
    for (;;) {
        sum = 0u; cnt = 0u; mine = 0u;
#pragma unroll
        for (unsigned j = 0; j < 16; ++j) { const unsigned c = xb_ld(&bar[XB_XCNT(j)]); sum += c; cnt += (c > 0u) ? 1u : 0u; mine = (j == x) ? c : mine; }
        if (sum == G) break;
        __builtin_amdgcn_s_sleep(1);
        if ((++sp & 255u) == 0u) { if (xb_ld(&bar[XB_TMO])) break; if (sp > XB_SPIN_CAP) { atomicAdd(&bar[XB_TMO], 1u); break; } }
    }
    nloc = mine > 0u ? mine : 1u; nx = cnt > 0u ? cnt : 1u;
}

__device__ __forceinline__ void xcd_barrier(const XcdBarrier& b) {
    asm volatile("s_waitcnt vmcnt(0)" ::: "memory");
    __syncthreads();
    if (b.wave == 0 && fresh_lane() == 0) {
        unsigned* bar = b.bar;
        __builtin_amdgcn_s_waitcnt(0);
        unsigned nloc = b.st[0], nx = b.st[1];
        if (nloc == 0u) { xcd_barrier_complete(bar, b.x, nloc, nx); b.st[0] = nloc; b.st[1] = nx; }
        const unsigned old = xb_add(&bar[XB_XSUB(b.x)], 1u);
        const unsigned gen = old / nloc;
        if (old + 1u == (gen + 1u) * nloc) {
            __builtin_amdgcn_fence(__ATOMIC_RELEASE, "agent");
            asm volatile("s_waitcnt vmcnt(0)" ::: "memory");
            const unsigned og = xb_add(&bar[XB_TOP], 1u);
            const unsigned tg = og / nx;
            if (og + 1u == (tg + 1u) * nx) xb_add(&bar[XB_TOPGEN], 1u);
            else XB_SPIN(xb_ld(&bar[XB_TOPGEN]) == tg, bar);
            __builtin_amdgcn_fence(__ATOMIC_ACQUIRE, "agent");
            xb_add(&bar[XB_XGEN(b.x)], 1u);
            asm volatile("s_waitcnt vmcnt(0)" ::: "memory");
        } else {
            XB_SPIN(xb_ld(&bar[XB_XGEN(b.x)]) == gen, bar);
            __builtin_amdgcn_fence(__ATOMIC_ACQUIRE, "agent");
            asm volatile("s_waitcnt vmcnt(0)" ::: "memory");
        }
    }
    __syncthreads();
}


struct Args { const float* in[23]; float* out; unsigned char* ws; };
enum { I_X = 0, I_F1N, I_F1WI, I_F1WO, I_MIXN, I_WIN, I_CONVW, I_CONVB, I_RGWA, I_RGBA, I_RGWX, I_RGBX, I_LAM, I_POOLW, I_POOLS, I_SGUN, I_SGUW, I_SGUB, I_WOUT, I_F2N, I_F2WI, I_F2WO, I_FINN };

__device__ __forceinline__ void transpose_block(const float* src, int lds_, const float* gain, bf16_t* dst, int ldd, int k0, int nd0, int sc0, bool valid, LAS float* scr, int lane) {
    const int c = lane & 7;
    if (!valid) {
#pragma unroll
        for (int j = 0; j < 4; ++j) { const int n = (lane >> 3) + 8 * j; *(u32x4*)(dst + (size_t)(nd0 + n) * ldd + k0 + 8 * c) = (u32x4){0u, 0u, 0u, 0u}; }
        return;
    }
#pragma unroll 16
    for (int i = 0; i < 32; ++i) { const int kk = 2 * i + (lane >> 5); float v = __builtin_nontemporal_load(src + (size_t)(k0 + kk) * lds_ + sc0 + (lane & 31)); if (gain) v *= gain[k0 + kk]; scr[kk * 33 + (lane & 31)] = v; }
    asm volatile("s_waitcnt lgkmcnt(0)" ::: "memory");
#pragma unroll
    for (int j = 0; j < 4; ++j) { const int n = (lane >> 3) + 8 * j; const LAS float* s = scr + (8 * c) * 33 + n;
        u32x4 o; o.x = cvt_pk_bf16(s[0 * 33], s[1 * 33]); o.y = cvt_pk_bf16(s[2 * 33], s[3 * 33]); o.z = cvt_pk_bf16(s[4 * 33], s[5 * 33]); o.w = cvt_pk_bf16(s[6 * 33], s[7 * 33]);
        *(u32x4*)(dst + (size_t)(nd0 + n) * ldd + k0 + 8 * c) = o; }
    asm volatile("s_waitcnt lgkmcnt(0)" ::: "memory");
}

__device__ __forceinline__ void prologue(const Args& a, LAS unsigned char* lds, int wave_s) {
    const int tid_ = fresh_tid(wave_s);
    const int tid = tid_, lane = tid & 63, wave = tid >> 6;
    const int gw = blockIdx.x * 8 + wave, NGW = gridDim.x * 8;
    unsigned char* ws = a.ws;
    LAS float* scr = (LAS float*)(lds + wave * 16384);
    constexpr int IT_FIN = (D / 64) * (NFF / 32), IT_FOUT = (DFFP / 64) * (D / 32), IT_WIN = (D / 64) * (DIN / 32), IT_WOUT = (D / 64) * (D / 32);
    constexpr int IT_L = 2 * IT_FIN + 2 * IT_FOUT + IT_WIN + IT_WOUT;
    for (int it = gw; it < DEPTH * IT_L; it += NGW) {
        const int l = it / IT_L; int r = it % IT_L;
        unsigned char* wl = ws + (size_t)l * WS_WL;
        if (r < 2 * IT_FIN) {
            const int f = r / IT_FIN; r %= IT_FIN; const int kb = r / (NFF / 32), nb = r % (NFF / 32);
            const int nd0 = nb * 32, pn = nd0 >> 8, bj = (nd0 >> 7) & 1, f0 = pn * 128 + (nd0 & 127);
            const float* src = a.in[f ? I_F2WI : I_F1WI] + (size_t)l * D * 2 * DFF; const float* gain = a.in[f ? I_F2N : I_F1N] + l * D;
            transpose_block(src, 2 * DFF, gain, (bf16_t*)(wl + (f ? WO_FFNIN1 : WO_FFNIN0)), D, kb * 64, nd0, bj * DFF + f0, f0 < DFF, scr, lane);
            continue;
        }
        r -= 2 * IT_FIN;
        if (r < 2 * IT_FOUT) {
            const int f = r / IT_FOUT; r %= IT_FOUT; const int kb = r / (D / 32), nb = r % (D / 32);
            const float* src = a.in[f ? I_F2WO : I_F1WO] + (size_t)l * DFF * D;
            transpose_block(src, D, nullptr, (bf16_t*)(wl + (f ? WO_FFNOUT1 : WO_FFNOUT0)), DFFP, kb * 64, nb * 32, nb * 32, kb * 64 < DFF, scr, lane);
            continue;
        }
        r -= 2 * IT_FOUT;
        if (r < IT_WIN) {
            const int kb = r / (DIN / 32), nb = r % (DIN / 32);
            transpose_block(a.in[I_WIN] + (size_t)l * D * DIN, DIN, a.in[I_MIXN] + l * D, (bf16_t*)(wl + WO_WIN), D, kb * 64, nb * 32, nb * 32, true, scr, lane);
            continue;
        }
        r -= IT_WIN;
        { const int kb = r / (D / 32), nb = r % (D / 32);
          transpose_block(a.in[I_WOUT] + (size_t)l * D * D, D, nullptr, (bf16_t*)(wl + WO_WOUT), D, kb * 64, nb * 32, nb * 32, true, scr, lane); }
    }
    const int gt = blockIdx.x * NTHREADS + tid, NGT = gridDim.x * NTHREADS;
    for (int i = gt; i < DEPTH * 8 * 64 * 64; i += NGT) {
        const int l = i >> 15, rem = i & 32767, h = rem >> 12, n = (rem >> 6) & 63, k = rem & 63;
        const size_t s = ((size_t)(l * 8 + h) * 64 + k) * 64 + n;
        bf16_t* sm = (bf16_t*)(ws + WS_SMALL + (size_t)l * SMALL_L);
        sm[SO_RGA / 2 + rem] = (bf16_t)(cvt_pk_bf16(a.in[I_RGWA][s] * -1.4426950409f, 0.f) & 0xffffu);
        sm[SO_RGX / 2 + rem] = (bf16_t)(cvt_pk_bf16(a.in[I_RGWX][s] * -1.4426950409f, 0.f) & 0xffffu);
    }
    for (int i = gt; i < DEPTH * 4 * 64 * 64; i += NGT) {
        const int l = i >> 14, rem = i & 16383, g = rem >> 12, n = (rem >> 6) & 63, k = rem & 63;
        const size_t s = ((size_t)(l * 4 + g) * 64 + k) * 64 + n;
        bf16_t* sm = (bf16_t*)(ws + WS_SMALL + (size_t)l * SMALL_L);
        sm[SO_POOL / 2 + rem] = (bf16_t)(cvt_pk_bf16(a.in[I_POOLW][s], 0.f) & 0xffffu);
    }
    for (int i = gt; i < DEPTH * 4 * 128 * 128; i += NGT) {
        const int l = i >> 16, rem = i & 65535, t = (rem >> 7) & 127, s = rem & 127;
        bf16_t* sm = (bf16_t*)(ws + WS_SMALL + (size_t)l * SMALL_L);
        const float v = (s <= t) ? a.in[I_SGUW][i] : 0.f;
        sm[SO_SGU / 2 + rem] = (bf16_t)(cvt_pk_bf16(v, 0.f) & 0xffffu);
    }
    u32s* rowss = (u32s*)(ws + WS_ROWSS);
    for (int i = gt; i < 6 * M; i += NGT) rowss[M + i] = 0u;
    bf16_t* XB = (bf16_t*)(ws + WS_XB);
    for (int m0 = gw * 4; m0 < M; m0 += NGW * 4) {
        f32x4 v[4][4];
#pragma unroll
        for (int i = 0; i < 4; ++i)
#pragma unroll
            for (int j = 0; j < 4; ++j) v[i][j] = __builtin_nontemporal_load((const f32x4*)(a.in[I_X] + (size_t)(m0 + i) * D) + lane + 64 * j);
#pragma unroll
        for (int i = 0; i < 4; ++i) {
            u32x2* o8 = (u32x2*)(XB + (size_t)(m0 + i) * D) + lane; float ss = 0.f;
#pragma unroll
            for (int j = 0; j < 4; ++j) { const f32x4 w = v[i][j]; ss += (w.x * w.x + w.y * w.y) + (w.z * w.z + w.w * w.w); o8[64 * j] = pack4(w); }
#pragma unroll
            for (int o = 1; o < 64; o <<= 1) ss += shfl_xor_l(ss, o, lane);
            if (lane == 0) rowss[m0 + i] = (u32s)(ss * SS_SCALE);
        }
    }
}

__device__ __forceinline__ void load_rglru_consts(const Args& a, int l, LAS float* cst, int wave_s) {
    const int ch = fresh_tid(wave_s);
#pragma unroll
    for (int k = 0; k < 4; ++k) cst[k * 512 + ch] = a.in[I_CONVW][(l * 4 + k) * 512 + ch];
    cst[4 * 512 + ch] = a.in[I_CONVB][l * 512 + ch];
    cst[5 * 512 + ch] = a.in[I_RGBA][l * 512 + ch] * -1.4426950409f;
    cst[6 * 512 + ch] = a.in[I_RGBX][l * 512 + ch] * -1.4426950409f;
    cst[7 * 512 + ch] = -1.0f / (8.0f * log1pf(expf(-a.in[I_LAM][l * 512 + ch])) * 1.4426950409f);
    __syncthreads();
}

template <bool FINAL>
__device__ __forceinline__ void rglru_phase(const Args& a, int l, LAS unsigned char* lds, int wave_s) {
    const int tid_ = fresh_tid(wave_s);
    const int tid = tid_, lane = tid & 63, h = tid >> 6, r = lane & 15, q = lane >> 4;
    unsigned char* ws = a.ws;
    const bf16_t* P = (const bf16_t*)(ws + WS_P); bf16_t* Y = (bf16_t*)(ws + WS_Y);
    float* sumA = (float*)(ws + WS_SUMA); float* sumH = (float*)(ws + WS_SUMH);
    LAS float* cst = (LAS float*)lds;
    const int chl = 64 * h + 4 * q;
    const bf16_t* sm = (const bf16_t*)(ws + WS_SMALL + (size_t)l * SMALL_L);
    bf16x8 WaF[4][2], WxF[4][2];
#pragma unroll
    for (int nt = 0; nt < 4; ++nt)
#pragma unroll
        for (int ks = 0; ks < 2; ++ks) {
            const size_t o = ((size_t)h * 64 + 16 * nt + r) * 64 + 32 * ks + 4 * q;
            WaF[nt][ks] = mk8(*(const u32x2*)(sm + SO_RGA / 2 + o), *(const u32x2*)(sm + SO_RGA / 2 + o + 16));
            WxF[nt][ks] = mk8(*(const u32x2*)(sm + SO_RGX / 2 + o), *(const u32x2*)(sm + SO_RGX / 2 + o + 16));
        }
    for (int it = blockIdx.x; it < BATCH * NCH; it += gridDim.x) {
        const int b = it / NCH, c = it % NCH;
        f32x4 cH[4], cA[4];
#pragma unroll
        for (int nt = 0; nt < 4; ++nt) { cH[nt] = (f32x4){0.f, 0.f, 0.f, 0.f}; cA[nt] = (f32x4){1.f, 1.f, 1.f, 1.f}; }
        if (FINAL) {
            f32x4 H1[4];
#pragma unroll
            for (int grp = 0; grp < 2; ++grp) {
                const int cp = r + 16 * grp; const bool valid = cp < c;
                const size_t so = ((size_t)(b * NCH + (valid ? cp : 0))) * 512 + chl;
#pragma unroll
                for (int nt = 0; nt < 4; ++nt) {
                    f32x4 A = *(const f32x4*)(sumA + so + 16 * nt), H = *(const f32x4*)(sumH + so + 16 * nt);
                    if (!valid) { A = (f32x4){1.f, 1.f, 1.f, 1.f}; H = (f32x4){0.f, 0.f, 0.f, 0.f}; }
#define SCAN_STEP(SH) _Pragma("unroll") for (int j = 0; j < 4; ++j) { const float Ap = dpp_shr<SH>(1.0f, A[j]), Hp = dpp_shr<SH>(0.0f, H[j]); H[j] = A[j] * Hp + H[j]; A[j] = A[j] * Ap; }
                    SCAN_STEP(1) SCAN_STEP(2) SCAN_STEP(4) SCAN_STEP(8)
#undef SCAN_STEP
                    if (grp == 0) H1[nt] = H; else cH[nt] = A * H1[nt] + H;
                }
            }
        }
        u32x2 nx[4][4];
#define RG_ISSUE(MT) do { const int pos_ = c * TCH + 16 * (MT) + r; const size_t tok_ = (size_t)b * SEQ + pos_; \
            _Pragma("unroll") for (int k = 0; k < 4; ++k) { _Pragma("unroll") for (int nt = 0; nt < 4; ++nt) nx[k][nt] = (u32x2){0u, 0u}; \
                if (pos_ - 3 + k >= 0) { _Pragma("unroll") for (int nt = 0; nt < 4; ++nt) nx[k][nt] = *(const u32x2*)(P + (tok_ - 3 + k) * DIN + 512 + chl + 16 * nt); } } \
            } while (0)
        RG_ISSUE(0);
#pragma unroll 1
        for (int mt = 0; mt < TCH / 16; ++mt) {
            asm volatile("" ::: "memory");
            const int pos = c * TCH + 16 * mt + r; const size_t tok = (size_t)b * SEQ + pos;
            f32x4 xc[4]; u32x2 gcur[4];
#pragma unroll
            for (int nt = 0; nt < 4; ++nt) { xc[nt] = *(const LAS f32x4*)(cst + 4 * 512 + chl + 16 * nt); if (FINAL) gcur[nt] = *(const u32x2*)(P + tok * DIN + chl + 16 * nt); }
#pragma unroll
            for (int k = 0; k < 4; ++k)
#pragma unroll
                for (int nt = 0; nt < 4; ++nt) xc[nt] += *(const LAS f32x4*)(cst + k * 512 + chl + 16 * nt) * unpack4(nx[k][nt]);
            __builtin_amdgcn_sched_barrier(0);
            if (mt + 1 < TCH / 16) RG_ISSUE(mt + 1);
            __builtin_amdgcn_sched_barrier(0);
            bf16x8 Xf[2];
#pragma unroll
            for (int ks = 0; ks < 2; ++ks) Xf[ks] = mk8(pack4(xc[2 * ks]), pack4(xc[2 * ks + 1]));
#pragma unroll
            for (int nt = 0; nt < 4; ++nt) {
                const f32x4 sp = *(const LAS f32x4*)(cst + 7 * 512 + chl + 16 * nt);
                f32x4 ar = *(const LAS f32x4*)(cst + 5 * 512 + chl + 16 * nt), ai = *(const LAS f32x4*)(cst + 6 * 512 + chl + 16 * nt);
#pragma unroll
                for (int ks = 0; ks < 2; ++ks) { ar = __builtin_amdgcn_mfma_f32_16x16x32_bf16(WaF[nt][ks], Xf[ks], ar, 0, 0, 0); ai = __builtin_amdgcn_mfma_f32_16x16x32_bf16(WxF[nt][ks], Xf[ks], ai, 0, 0, 0); }
                f32x4 A, H;
#pragma unroll
                for (int j = 0; j < 4; ++j) {
                    const float ii = __builtin_amdgcn_rcpf(1.0f + __builtin_amdgcn_exp2f(ai[j]));
                    const float av = __builtin_amdgcn_exp2f(__builtin_amdgcn_rcpf(__builtin_fmaf(__builtin_amdgcn_exp2f(ar[j]), sp[j], sp[j])));
                    const float mult = __builtin_amdgcn_sqrtf(1.0f - av * av);
                    A[j] = av; H[j] = mult * (ii * xc[nt][j]);
                }
#pragma unroll
                for (int j = 0; j < 4; ++j) {
                    const float hin = (!FINAL && mt == 0) ? cH[nt][j] : dpp_ror1(cH[nt][j]);
                    const float Hn = A[j] * hin + H[j];
                    H[j] = (r == 0) ? Hn : H[j];
                    if (!FINAL) { const float ain = (mt == 0) ? cA[nt][j] : dpp_ror1(cA[nt][j]); const float An = A[j] * ain; A[j] = (r == 0) ? An : A[j]; }
                }
#define SCAN_STEP(SH) _Pragma("unroll") for (int j = 0; j < 4; ++j) { const float Ap = dpp_shr<SH>(1.0f, A[j]), Hp = dpp_shr<SH>(0.0f, H[j]); H[j] = A[j] * Hp + H[j]; A[j] = A[j] * Ap; }
                SCAN_STEP(1) SCAN_STEP(2) SCAN_STEP(4) SCAN_STEP(8)
#undef SCAN_STEP
                cH[nt] = H;
                __builtin_amdgcn_sched_barrier(0);
                if (FINAL) {
                    const f32x4 g = gelu4(unpack4(gcur[nt]));
                    *(u32x2*)(Y + tok * D + chl + 16 * nt) = pack4(g * H);
                } else {
                    cA[nt] = A;
                }
            }
        }
#undef RG_ISSUE
        if (!FINAL && r == 15) {
            const size_t so = ((size_t)(b * NCH + c)) * 512 + chl;
#pragma unroll
            for (int nt = 0; nt < 4; ++nt) { *(f32x4*)(sumA + so + 16 * nt) = cA[nt]; *(f32x4*)(sumH + so + 16 * nt) = cH[nt]; }
        }
    }
}

__device__ __forceinline__ void pool_phase(const Args& a, int l, int wave_s) {
    const int tid_ = fresh_tid(wave_s);
    const int tid = tid_, lane = tid & 63, wave = tid >> 6, r = lane & 15, q = lane >> 4, g = wave & 3, half = wave >> 2;
    unsigned char* ws = a.ws;
    const bf16_t* P = (const bf16_t*)(ws + WS_P); bf16_t* Y = (bf16_t*)(ws + WS_Y);
    const bf16_t* sm = (const bf16_t*)(ws + WS_SMALL + (size_t)l * SMALL_L) + SO_POOL / 2;
    const int chl = 64 * g + 4 * q, win = 2 << g;
    bf16x8 PF[4][2]; f32x4 sc[4];
#pragma unroll
    for (int nt = 0; nt < 4; ++nt) {
        sc[nt] = *(const f32x4*)(a.in[I_POOLS] + l * DPOOL + chl + 16 * nt);
#pragma unroll
        for (int ks = 0; ks < 2; ++ks) { const size_t o = ((size_t)g * 64 + 16 * nt + r) * 64 + 32 * ks + 4 * q; PF[nt][ks] = mk8(*(const u32x2*)(sm + o), *(const u32x2*)(sm + o + 16)); }
    }
    for (int it = blockIdx.x; it < M / 128; it += gridDim.x) {
        const int b = it / (SEQ / 128), pos0 = (it % (SEQ / 128)) * 128 + half * 64;
#pragma unroll 1
        for (int mt = 0; mt < 4; ++mt) {
            const int pos = pos0 + 16 * mt + r; const size_t tok = (size_t)b * SEQ + pos;
            f32x4 sum[4], x0[4], sp[4];
#pragma unroll
            for (int nt = 0; nt < 4; ++nt) { x0[nt] = unpack4(*(const u32x2*)(P + tok * DIN + 1024 + chl + 16 * nt)); sum[nt] = x0[nt]; sp[nt] = (f32x4){0.f, 0.f, 0.f, 0.f}; }
            if (pos0 + 16 * mt >= 16) {
#pragma unroll
                for (int nt = 0; nt < 4; ++nt) sp[nt] = unpack4(*(const u32x2*)(P + (tok - 16) * DIN + 1024 + chl + 16 * nt));
            }
#define POOL_STEP(K) if (win > (K)) { _Pragma("unroll") for (int nt = 0; nt < 4; ++nt) _Pragma("unroll") for (int j = 0; j < 4; ++j) { \
                const float tc = dpp_ror<K>(sum[nt][j]), tp = dpp_ror<K>(sp[nt][j]); sum[nt][j] += (r >= (K)) ? tc : tp; sp[nt][j] += tp; } }
            POOL_STEP(1) POOL_STEP(2) POOL_STEP(4) POOL_STEP(8)
#undef POOL_STEP
            const float inv = 1.0f / (float)((pos + 1 < win) ? pos + 1 : win);
            f32x4 d[4];
#pragma unroll
            for (int nt = 0; nt < 4; ++nt) d[nt] = sum[nt] * inv - x0[nt];
            bf16x8 Xf[2];
#pragma unroll
            for (int ks = 0; ks < 2; ++ks) Xf[ks] = mk8(pack4(d[2 * ks]), pack4(d[2 * ks + 1]));
#pragma unroll
            for (int nt = 0; nt < 4; ++nt) {
                f32x4 acc = (f32x4){0.f, 0.f, 0.f, 0.f};
                acc = __builtin_amdgcn_mfma_f32_16x16x32_bf16(PF[nt][0], Xf[0], acc, 0, 0, 0);
                acc = __builtin_amdgcn_mfma_f32_16x16x32_bf16(PF[nt][1], Xf[1], acc, 0, 0, 0);
                *(u32x2*)(Y + tok * D + 512 + chl + 16 * nt) = pack4(acc * sc[nt]);
            }
        }
    }
}

constexpr int VP = 136;
__device__ __forceinline__ void sgu_phase(const Args& a, int l, LAS unsigned char* lds, int wave_s) {
    const int tid_ = fresh_tid(wave_s);
    const int tid = tid_, lane = tid & 63, wave = tid >> 6, r = lane & 15, q = lane >> 4;
    unsigned char* ws = a.ws;
    const bf16_t* P = (const bf16_t*)(ws + WS_P); bf16_t* Y = (bf16_t*)(ws + WS_Y);
    const bf16_t* sw = (const bf16_t*)(ws + WS_SMALL + (size_t)l * SMALL_L) + SO_SGU / 2;
    LAS bf16_t* Vt = (LAS bf16_t*)(lds + 16384);
    for (int it = blockIdx.x; it < M / 128; it += gridDim.x) {
        const size_t tok0 = (size_t)it * 128;
        {
            const size_t tok = tok0 + 16 * wave + r;
            f32x4 v[16]; float ss = 0.f;
#pragma unroll
            for (int i = 0; i < 16; ++i) { v[i] = gelu4(unpack4(*(const u32x2*)(P + tok * DIN + 1536 + 16 * i + 4 * q))); ss += (v[i].x * v[i].x + v[i].y * v[i].y) + (v[i].z * v[i].z + v[i].w * v[i].w); }
            ss += shfl_xor_l(ss, 16, lane); ss += shfl_xor_l(ss, 32, lane);
            const float rstd = __builtin_amdgcn_rsqf(ss * (1.0f / DSGU) + EPS);
#pragma unroll
            for (int i = 0; i < 16; ++i) {
                const f32x4 gn = *(const f32x4*)(a.in[I_SGUN] + l * DSGU + 16 * i + 4 * q);
                const f32x4 o = v[i] * gn * rstd;
                const u32x2 w = pack4(o);
                LAS bf16_t* dst = Vt + (16 * i + 4 * q) * VP + 16 * wave + r;
                dst[0] = (bf16_t)(w.x & 0xffffu); dst[VP] = (bf16_t)(w.x >> 16); dst[2 * VP] = (bf16_t)(w.y & 0xffffu); dst[3 * VP] = (bf16_t)(w.y >> 16);
            }
        }
        __syncthreads();
        {
            const int hh = wave & 3, grp = wave >> 2;
#pragma unroll 1
            for (int mi = 0; mi < 4; ++mi) {
                const int aa = 2 * grp + (mi >> 1), mt = (mi & 1) ? 7 - aa : aa, nks = (mt >> 1) + 1;
                f32x4 acc[4];
#pragma unroll
                for (int nt = 0; nt < 4; ++nt) acc[nt] = (f32x4){0.f, 0.f, 0.f, 0.f};
                const bf16_t* Wrow = sw + ((size_t)hh * 128 + 16 * mt + r) * 128 + 8 * q;
                const size_t tok = tok0 + 16 * mt + r;
                bf16x8 Wf[4]; u32x2 uw[4];
#pragma unroll
                for (int ks = 0; ks < 4; ++ks) Wf[ks] = *(const bf16x8*)(Wrow + 32 * (ks < nks ? ks : 0));
#pragma unroll
                for (int nt = 0; nt < 4; ++nt) uw[nt] = *(const u32x2*)(P + tok * DIN + 1280 + 64 * hh + 16 * nt + 4 * q);
                const float bias = a.in[I_SGUB][(l * 4 + hh) * 128 + 16 * mt + r];
#pragma unroll
                for (int ks = 0; ks < 4; ++ks) {
                    if (ks < nks) {
#pragma unroll
                        for (int nt = 0; nt < 4; ++nt) {
                            const bf16x8 Vf = *(const LAS bf16x8*)(Vt + (64 * hh + 16 * nt + r) * VP + 32 * ks + 8 * q);
                            acc[nt] = __builtin_amdgcn_mfma_f32_16x16x32_bf16(Vf, Wf[ks], acc[nt], 0, 0, 0);
                        }
                    }
                }
#pragma unroll
                for (int nt = 0; nt < 4; ++nt) {
                    const f32x4 uu = gelu4(unpack4(uw[nt]));
                    *(u32x2*)(Y + tok * D + 768 + 64 * hh + 16 * nt + 4 * q) = pack4(uu * (acc[nt] + bias));
                }
            }
        }
        __syncthreads();
    }
}

__device__ __forceinline__ void final_norm(const Args& a, int wave_s) {
    const int tid_ = fresh_tid(wave_s);
    const int tid = tid_, lane = tid & 63, wave = tid >> 6;
    const int gw = blockIdx.x * 8 + wave, NGW = gridDim.x * 8;
    const u32s* rowss = (const u32s*)(a.ws + WS_ROWSS) + (size_t)6 * M;
    f32x4 fn[4];
#pragma unroll
    for (int j = 0; j < 4; ++j) fn[j] = *((const f32x4*)a.in[I_FINN] + lane + 64 * j);
    const bf16_t* XB = (const bf16_t*)(a.ws + WS_XB);
    for (int m0 = gw * 4; m0 < M; m0 += NGW * 4) {
        u32x2 xi[4][4]; float rstd[4];
#pragma unroll
        for (int i = 0; i < 4; ++i) {
            rstd[i] = __builtin_amdgcn_rsqf((float)rowss[m0 + i] * (SS_INV / D) + EPS);
#pragma unroll
            for (int j = 0; j < 4; ++j) xi[i][j] = ((const u32x2*)(XB + (size_t)(m0 + i) * D) + lane)[64 * j];
        }
#pragma unroll
        for (int i = 0; i < 4; ++i) {
            f32x4* o = (f32x4*)(a.out + (size_t)(m0 + i) * D) + lane;
#pragma unroll
            for (int j = 0; j < 4; ++j) __builtin_nontemporal_store(unpack4(xi[i][j]) * rstd[i] * fn[j], &o[64 * j]);
        }
    }
}

#ifdef DBL_SYNC
#define GSYNC() do { xcd_barrier(xbar); xcd_barrier(xbar); } while (0)
#else
#define GSYNC() xcd_barrier(xbar)
#endif
#ifndef PEEL_G1
#define PEEL_G1 true
#endif
#ifndef PEEL_G2
#define PEEL_G2 true
#endif
#ifndef PEEL_G3
#define PEEL_G3 true
#endif
#ifndef PEEL_G4
#define PEEL_G4 true
#endif
__global__ void __launch_bounds__(NTHREADS, 2) mega_fwd(Args a) {
    extern __shared__ __attribute__((aligned(16))) unsigned char lds_raw[];
    LAS unsigned char* lds = (LAS unsigned char*)lds_raw;
    cg::grid_group grid = cg::this_grid();
    unsigned char* ws = a.ws;
    bf16_t* XB = (bf16_t*)(ws + WS_XB); bf16_t* ACT = (bf16_t*)(ws + WS_ACT); bf16_t* PB = (bf16_t*)(ws + WS_P); bf16_t* YB = (bf16_t*)(ws + WS_Y);
    u32s* rowss = (u32s*)(ws + WS_ROWSS);
    const int G = gridDim.x, bid = blockIdx.x;

    const int wave_s = __builtin_amdgcn_readfirstlane((int)(threadIdx.x >> 6));
    { volatile LAS unsigned* st = (volatile LAS unsigned*)(lds + 131072); if (threadIdx.x < 16) st[threadIdx.x] = 0u; }
    __syncthreads();
    const XcdBarrier xbar = xcd_barrier_post((unsigned*)(ws + WS_CTL), (volatile LAS unsigned*)(lds + 131072), wave_s);
    prologue(a, lds, wave_s);
#ifdef DBL_PRO
    prologue(a, lds, wave_s);
#endif
    if (a.ws == nullptr) grid.sync();
    xcd_barrier(xbar);

    int nrm = 0;
#pragma unroll 1
    for (int l = 0; l < DEPTH; ++l) {
        const unsigned char* wl = ws + (size_t)l * WS_WL;
#pragma unroll 1
        for (int f = 0; f < 2; ++f) {
            {
                pg8::Gemm g{XB, (const bf16_t*)(wl + (f ? WO_FFNIN1 : WO_FFNIN0)), M, NFF, D}; pg8::StaticOrder S; S.init(M, NFF, G, bid);
                pg8::EpiSwiGLU E{ACT, rowss + (size_t)nrm * M};
                pg8::gemm_phase<pg8::EpiSwiGLU, false, PEEL_G1, NFF / 256>(lds, g, S, E, wave_s);
#ifdef DBL_G1
                pg8::gemm_phase(lds, g, S, E, wave_s);
#endif
            }
            GSYNC();
            {
                pg8::Gemm g{ACT, (const bf16_t*)(wl + (f ? WO_FFNOUT1 : WO_FFNOUT0)), M, D, DFFP}; pg8::StaticOrder S; S.init(M, D, G, bid);
                pg8::EpiResid E{XB, rowss + (size_t)(nrm + 1) * M, 0.5f};
                pg8::gemm_phase<pg8::EpiResid, true, PEEL_G2, D / 256>(lds, g, S, E, wave_s);
            }
            ++nrm;
            GSYNC();
            if (f == 0) {
                {
                    pg8::Gemm g{XB, (const bf16_t*)(wl + WO_WIN), M, DIN, D}; pg8::StaticOrder S; S.init(M, DIN, G, bid);
                    pg8::EpiP E{PB, rowss + (size_t)nrm * M};
                    pg8::gemm_phase<pg8::EpiP, false, PEEL_G3, DIN / 256>(lds, g, S, E, wave_s);
#ifdef DBL_G3
                    pg8::gemm_phase(lds, g, S, E, wave_s);
#endif
                }
                GSYNC();
                load_rglru_consts(a, l, (LAS float*)lds, wave_s);
                rglru_phase<false>(a, l, lds, wave_s);
#ifdef DBL_M1A
                rglru_phase<false>(a, l, lds, wave_s);
#endif
                pool_phase(a, l, wave_s);
#ifdef DBL_POOL
                pool_phase(a, l, wave_s);
#endif
                sgu_phase(a, l, lds, wave_s);
#ifdef DBL_SGU
                sgu_phase(a, l, lds, wave_s);
#endif
                GSYNC();
                rglru_phase<true>(a, l, lds, wave_s);
#ifdef DBL_M2
                rglru_phase<true>(a, l, lds, wave_s);
#endif
                GSYNC();
                {
                    pg8::Gemm g{YB, (const bf16_t*)(wl + WO_WOUT), M, D, D}; pg8::StaticOrder S; S.init(M, D, G, bid);
                    pg8::EpiResid E{XB, rowss + (size_t)(nrm + 1) * M, 1.0f};
                    pg8::gemm_phase<pg8::EpiResid, false, PEEL_G4, D / 256>(lds, g, S, E, wave_s);
                }
                ++nrm;
                GSYNC();
            }
        }
    }
    final_norm(a, wave_s);
}

extern "C" void kernel_launch(void* const* d_in, const int* in_sizes, int n_in, void* d_out, int out_size, void* d_ws, size_t ws_size, hipStream_t stream) {
    static int grid = 0;
    if (grid == 0) {
        if (n_in != 23 || in_sizes[0] != M * D || out_size != M * D || ws_size < WS_END) { fprintf(stderr, "kernel_launch: unexpected shapes (n_in %d, in0 %d, out %d, ws %zu)\n", n_in, n_in > 0 ? in_sizes[0] : -1, out_size, ws_size); grid = -1; return; }
        int dev = 0, cus = 0, per_cu = 0;
        hipGetDevice(&dev); hipDeviceGetAttribute(&cus, hipDeviceAttributeMultiprocessorCount, dev);
        if (hipFuncSetAttribute((const void*)mega_fwd, hipFuncAttributeMaxDynamicSharedMemorySize, LDS_BYTES) != hipSuccess) { fprintf(stderr, "kernel_launch: hipFuncSetAttribute failed\n"); }
        if (hipOccupancyMaxActiveBlocksPerMultiprocessor(&per_cu, (const void*)mega_fwd, NTHREADS, LDS_BYTES) != hipSuccess || per_cu < 1) { fprintf(stderr, "kernel_launch: occupancy query says %d\n", per_cu); per_cu = 1; }
        (void)hipGetLastError();
        grid = cus * 1;
        if (grid <= 0) grid = 256;
    }
    if (grid < 0) return;
    Args a{};
    for (int i = 0; i < 23; ++i) a.in[i] = (const float*)d_in[i];
    a.out = (float*)d_out; a.ws = (unsigned char*)d_ws;
    if (hipMemsetAsync((char*)d_ws + WS_CTL, 0, CTL_BYTES, stream) != hipSuccess) { fprintf(stderr, "kernel_launch: memset failed\n"); return; }
    void* args[] = {&a};
    hipError_t e = hipLaunchCooperativeKernel((const void*)mega_fwd, dim3(grid), dim3(NTHREADS), args, LDS_BYTES, stream);
    if (e != hipSuccess) fprintf(stderr, "kernel_launch: cooperative launch failed: %s (grid %d)\n", hipGetErrorString(e), grid);
}
```

```cpp
#include <hip/hip_runtime.h>
#include <hip/hip_cooperative_groups.h>
#include <cstdio>
namespace cg = cooperative_groups;

#define LAS __attribute__((address_space(3)))
typedef unsigned short bf16_t;
typedef short bf16x8 __attribute__((ext_vector_type(8)));
typedef float f32x4 __attribute__((ext_vector_type(4)));
typedef unsigned u32x4 __attribute__((ext_vector_type(4)));
typedef unsigned u32x2 __attribute__((ext_vector_type(2)));
typedef unsigned u32s;
constexpr float SS_SCALE = 16384.0f, SS_INV = 1.0f / 16384.0f;

constexpr int D = 1024, BATCH = 8, SEQ = 8192, M = BATCH * SEQ, DEPTH = 2;
constexpr int DRNN = 512, DPOOL = 256, DSGU = 256, DIN = 1792, DFF = 2752, DFFP = 2816, NFF = 2 * DFFP;
constexpr int TCH = 256, NCH = SEQ / TCH;
constexpr float EPS = 1e-6f;
constexpr int NTHREADS = 512;
constexpr int LDS_RS = 131072 + 64;
constexpr int LDS_BYTES = 131072 + 64 + 1024;

constexpr size_t MiB = 1u << 20;
constexpr size_t WS_WL = 40 * MiB;
constexpr size_t WO_FFNIN0 = 0, WO_FFNOUT0 = 11 * MiB, WO_FFNIN1 = 17 * MiB, WO_FFNOUT1 = 28 * MiB, WO_WIN = 34 * MiB, WO_WOUT = 38 * MiB;
constexpr size_t WS_SMALL = 80 * MiB, SMALL_L = 512 * 1024;
constexpr size_t SO_RGA = 0, SO_RGX = 65536, SO_POOL = 131072, SO_SGU = 163840;
constexpr size_t WS_ROWSS = 81 * MiB;
constexpr size_t WS_SUMA = 85 * MiB, WS_SUMH = 85 * MiB + 512 * 1024;
constexpr size_t WS_XB = 86 * MiB;
constexpr size_t WS_ACT = 214 * MiB;
constexpr size_t WS_P = WS_ACT, WS_Y = WS_ACT + 224 * MiB;
constexpr size_t WS_END = 566 * MiB;
constexpr size_t WS_CTL = 84 * MiB + 768 * 1024, CTL_BYTES = 16384;

__device__ __forceinline__ unsigned cvt_pk_bf16(float lo, float hi) { unsigned r; asm("v_cvt_pk_bf16_f32 %0, %1, %2" : "=v"(r) : "v"(lo), "v"(hi)); return r; }
__device__ __forceinline__ f32x4 unpack4(u32x2 w) { f32x4 v; v.x = __uint_as_float(w.x << 16); v.y = __uint_as_float(w.x & 0xffff0000u); v.z = __uint_as_float(w.y << 16); v.w = __uint_as_float(w.y & 0xffff0000u); return v; }
__device__ __forceinline__ u32x2 pack4(f32x4 v) { u32x2 w; w.x = cvt_pk_bf16(v.x, v.y); w.y = cvt_pk_bf16(v.z, v.w); return w; }
__device__ __forceinline__ float sigmoidf_(float z) { return __builtin_amdgcn_rcpf(1.0f + __expf(-z)); }
__device__ __forceinline__ float gelu_t(float x) { const float w = __builtin_fmaf(x * x, -0.1029432395f, -2.3022082003f); return x * __builtin_amdgcn_rcpf(1.0f + __builtin_amdgcn_exp2f(x * w)); }
__device__ __forceinline__ f32x4 gelu4(f32x4 v) { f32x4 o; o.x = gelu_t(v.x); o.y = gelu_t(v.y); o.z = gelu_t(v.z); o.w = gelu_t(v.w); return o; }
__device__ __forceinline__ bf16x8 mk8(u32x2 lo, u32x2 hi) { u32x4 v; v.x = lo.x; v.y = lo.y; v.z = hi.x; v.w = hi.y; return __builtin_bit_cast(bf16x8, v); }
__device__ __forceinline__ int fresh_lane() { int lane; asm volatile("v_mbcnt_lo_u32_b32 %0, -1, 0\n\tv_mbcnt_hi_u32_b32 %0, -1, %0" : "=v"(lane)); return lane; }
__device__ __forceinline__ int fresh_tid(int wave_s) { return wave_s * 64 + fresh_lane(); }
__device__ __forceinline__ float shfl_xor_l(float v, int mask, int lane) { return __builtin_bit_cast(float, __builtin_amdgcn_ds_bpermute((lane ^ mask) << 2, __builtin_bit_cast(int, v))); }
template <int SH> __device__ __forceinline__ float dpp_shr0(float v) { return __builtin_bit_cast(float, __builtin_amdgcn_mov_dpp(__builtin_bit_cast(int, v), 0x110 + SH, 0xf, 0xf, true)); }
template <int SH> __device__ __forceinline__ float dpp_shr(float old, float v) {
    return __builtin_bit_cast(float, __builtin_amdgcn_update_dpp(__builtin_bit_cast(int, old), __builtin_bit_cast(int, v), 0x110 + SH, 0xf, 0xf, false));
}

template <int K> __device__ __forceinline__ float dpp_ror(float v) {
    return __builtin_bit_cast(float, __builtin_amdgcn_mov_dpp(__builtin_bit_cast(int, v), 0x120 + K, 0xf, 0xf, false));
}
__device__ __forceinline__ float dpp_ror1(float v) { return dpp_ror<1>(v); }

#ifndef RESID_DEPTH
#define RESID_DEPTH 8
#endif
namespace pg8 {
constexpr int BM = 256, BK = 64, HALF = 128, HTB = HALF * BK * 2, STAGE_BYTES = 8 * HTB, NXCD = 8, WGM = 8;
__host__ __device__ __forceinline__ int lds_byte(int r, int c) { const int st = (r >> 4) * 2 + (c >> 5), rr = r & 15, cc = c & 31, ob = rr * 64 + cc * 2; return st * 1024 + (ob ^ (((ob >> 9) & 1) << 5)); }
__host__ __device__ __forceinline__ void stage_rc(int b, int& R, int& C) { const int st = b / 1024, sb = b % 1024, swz = sb ^ (((sb >> 9) & 1) << 5); R = (st >> 1) * 16 + swz / 64; C = (st & 1) * 32 + (swz % 64) / 2; }
__host__ __device__ __forceinline__ int perm32(int rho) { const int n = rho >> 4, i = rho & 15; return 8 * (i >> 2) + 4 * n + (i & 3); }
struct Unit { int pm, pn; };
struct Gemm { const bf16_t* A; const bf16_t* Bt; int M, N, K; };
struct StaticOrder {
    int nM, nN, nwg, G, c;
    __device__ void init(int M_, int N_, int G_, int c_) { nM = M_ / BM; nN = N_ / BM; nwg = nM * nN; G = G_; c = c_; }
    __device__ bool next(int i, Unit& u) const {
        const long L = (long)i * G + c; if (L >= nwg) return false;
        int wgid = (int)L; { const int q = nwg / NXCD, r = nwg % NXCD, xcd = wgid % NXCD, off = wgid / NXCD; wgid = (xcd < r ? xcd * (q + 1) : r * (q + 1) + (xcd - r) * q) + off; }
        const int nig = WGM * nN, gid = wgid / nig, fm = gid * WGM, gsz = (nM - fm) < WGM ? (nM - fm) : WGM;
        u.pm = fm + ((wgid % nig) % gsz); u.pn = (wgid % nig) / gsz; return true;
    }
    template <int NN> __device__ __forceinline__ bool next_c(int i, Unit& u) const {
        const int L = i * G + c; if (L >= nwg) return false;
        const int wgid = (L & 7) * (nwg >> 3) + (L >> 3);
        constexpr int nig = WGM * NN; const int gid = wgid / nig, rem = wgid - gid * nig;
        u.pm = gid * WGM + (rem & (WGM - 1)); u.pn = rem / WGM; return true;
    }
};

template <class Epi, bool ABLK = false, bool PEEL = true, int NN = 0>
__device__ __forceinline__ void gemm_phase(LAS unsigned char* lds, const Gemm g, const StaticOrder& S, const Epi& E, int wave_s) {
    const int tid_ = fresh_tid(wave_s);
    const int tid = tid_, wid = __builtin_amdgcn_readfirstlane(tid >> 6), lane = tid & 63, wr = wid >> 2, wc = wid & 3, fr = lane & 15, fq = lane >> 4;
    const int K = g.K, nt = K / BK;
    unsigned voffA[2], voffB[2];
#pragma unroll
    for (int i = 0; i < 2; ++i) { int R, C; stage_rc(tid * 16 + i * 8192, R, C); const int Rb = Epi::PERM ? ((R & ~31) + perm32(R & 31)) : R;
        voffA[i] = ABLK ? (unsigned)(R * BK + C) * 2u : (unsigned)(R * K + C) * 2u; voffB[i] = (unsigned)(Rb * K + C) * 2u; }
    const size_t kstep = (size_t)(BK * 2);
    const size_t hstep = (size_t)HALF * K * 2;
    const size_t tstep = 2 * hstep;
    const size_t kstepA = ABLK ? (size_t)(BM * BK * 2) : kstep, hstepA = ABLK ? (size_t)(HALF * BK * 2) : hstep;
    const unsigned ldsw = (unsigned)wid * 1024u;
    const unsigned ldsb = (unsigned)(unsigned long)lds + ldsw;
    const int aoff = lds_byte(wr * 64 + fr, fq * 8), boff = lds_byte(wc * 32 + fr, fq * 8);
#define PG8_SA(b, h) (((b) * 2 + (h)) * HTB)
#define PG8_SB(b, h) ((4 + (b) * 2 + (h)) * HTB)
  \

#define PG8_STAGE(bufoff, gbase, voff) do { unsigned keep_; \
        asm volatile("s_mov_b32 %0, m0\n\ts_mov_b32 m0, %3\n\ts_nop 0\n\tglobal_load_lds_dwordx4 %1, %5\n\ts_mov_b32 m0, %4\n\ts_nop 0\n\tglobal_load_lds_dwordx4 %2, %5\n\ts_mov_b32 m0, %0" \
            : "=&s"(keep_) : "v"((voff)[0]), "v"((voff)[1]), "s"(ldsb + (unsigned)(bufoff)), "s"(ldsb + (unsigned)(bufoff) + 8192u), "s"((const void*)(gbase)) : "memory"); } while (0)
#define PG8_LDA(dst, b, h) do { _Pragma("unroll") for (int m = 0; m < 4; ++m) _Pragma("unroll") for (int k = 0; k < 2; ++k) dst[m][k] = *(const LAS bf16x8*)(lds + PG8_SA(b, h) + aoff + m * 2048 + k * 1024); } while (0)
#define PG8_LDB(dst, b, h) do { _Pragma("unroll") for (int n = 0; n < 2; ++n) _Pragma("unroll") for (int k = 0; k < 2; ++k) dst[n][k] = *(const LAS bf16x8*)(lds + PG8_SB(b, h) + boff + n * 2048 + k * 1024); } while (0)
#define PG8_MMA(ai, bj, At, Bt, ZC) do { __builtin_amdgcn_s_setprio(1); _Pragma("unroll") for (int m = 0; m < 4; ++m) _Pragma("unroll") for (int n = 0; n < 2; ++n) _Pragma("unroll") for (int k = 0; k < 2; ++k) \
        acc[ai][bj][m][n] = __builtin_amdgcn_mfma_f32_16x16x32_bf16(Bt[n][k], At[m][k], ((ZC) && k == 0) ? (f32x4){0.f, 0.f, 0.f, 0.f} : acc[ai][bj][m][n], 0, 0, 0); __builtin_amdgcn_s_setprio(0); } while (0)
#define PG8_WAIT_V(n) asm volatile("s_waitcnt vmcnt(" #n ")" ::: "memory")
#define PG8_WAIT_L(n) asm volatile("s_waitcnt lgkmcnt(" #n ")" ::: "memory")
#define PG8_BAR __builtin_amdgcn_s_barrier()
#define PG8_SCHED __builtin_amdgcn_sched_barrier(0)
#define PG8_BODY(FK) do { \
            const char* a1 = cA + (size_t)(t + 1) * kstepA; \
            const char* a2 = last ? nA : cA + (size_t)(t + 2) * kstepA; const char* b2 = last ? nB : cB + (size_t)(t + 2) * kstep; \
            const char* a3 = a2 + kstepA; const char* b3 = b2 + kstep; \
            if (last) E.stage(lds, cur, wid, fresh_lane()); \
            PG8_LDB(B0, 0, 0); PG8_SCHED; PG8_LDA(At, 0, 0); PG8_STAGE(PG8_SA(1, 1), a1 + hstepA, voffA); \
            PG8_WAIT_L(8); PG8_BAR; PG8_WAIT_L(0); PG8_MMA(0, 0, At, B0, FK); PG8_BAR; PG8_SCHED; \
            PG8_LDB(B1, 0, 1); PG8_STAGE(PG8_SB(0, 0), b2, voffB); \
            PG8_BAR; PG8_WAIT_L(0); PG8_MMA(0, 1, At, B1, FK); PG8_BAR; \
            PG8_LDA(At, 0, 1); PG8_STAGE(PG8_SA(0, 0), a2, voffA); \
            PG8_BAR; PG8_WAIT_L(0); PG8_MMA(1, 0, At, B0, FK); PG8_BAR; PG8_SCHED; \
            PG8_STAGE(PG8_SB(0, 1), b2 + hstep, voffB); \
            PG8_WAIT_V(6); PG8_BAR; PG8_MMA(1, 1, At, B1, FK); PG8_BAR; \
            PG8_LDB(B0, 1, 0); PG8_SCHED; PG8_LDA(At, 1, 0); PG8_STAGE(PG8_SA(0, 1), a2 + hstepA, voffA); \
            PG8_WAIT_L(8); PG8_BAR; PG8_WAIT_L(0); PG8_MMA(0, 0, At, B0, false); PG8_BAR; PG8_SCHED; \
            PG8_LDB(B1, 1, 1); PG8_STAGE(PG8_SB(1, 0), b3, voffB); \
            PG8_BAR; PG8_WAIT_L(0); PG8_MMA(0, 1, At, B1, false); PG8_BAR; \
            PG8_LDA(At, 1, 1); PG8_STAGE(PG8_SA(1, 0), a3, voffA); \
            PG8_BAR; PG8_WAIT_L(0); PG8_MMA(1, 0, At, B0, false); PG8_BAR; PG8_SCHED; \
            PG8_STAGE(PG8_SB(1, 1), b3 + hstep, voffB); \
            PG8_WAIT_V(6); PG8_BAR; PG8_MMA(1, 1, At, B1, false); PG8_BAR; \
        } while (0)
    Unit cur, nxt; int ui = 0;
    if (!(NN ? S.template next_c<(NN ? NN : 1)>(0, cur) : S.next(0, cur))) return;
    f32x4 acc[2][2][4][2];
    bf16x8 At[4][2], B0[2][2], B1[2][2];
    const char* cA = (const char*)g.A + (size_t)cur.pm * tstep; const char* cB = (const char*)g.Bt + (size_t)cur.pn * tstep;
    PG8_STAGE(PG8_SB(0, 0), cB, voffB); PG8_STAGE(PG8_SA(0, 0), cA, voffA); PG8_STAGE(PG8_SB(0, 1), cB + hstep, voffB); PG8_STAGE(PG8_SA(0, 1), cA + hstepA, voffA);
    if (wr == 1) PG8_BAR;
    PG8_WAIT_V(4); PG8_BAR;
    PG8_STAGE(PG8_SB(1, 0), cB + kstep, voffB); PG8_STAGE(PG8_SA(1, 0), cA + kstepA, voffA); PG8_STAGE(PG8_SB(1, 1), cB + hstep + kstep, voffB);
    PG8_WAIT_V(6); PG8_BAR;
    for (;;) {
        const bool has_next = NN ? S.template next_c<(NN ? NN : 1)>(ui + 1, nxt) : S.next(ui + 1, nxt);
        const char* nA = has_next ? (const char*)g.A + (size_t)nxt.pm * tstep : cA; const char* nB = has_next ? (const char*)g.Bt + (size_t)nxt.pn * tstep : cB;
        if constexpr (PEEL) {
            PG8_SCHED;
            { const int t = 0; const bool last = false; PG8_BODY(true); }
            for (int t = 2; t < nt; t += 2) { const bool last = (t == nt - 2); PG8_BODY(false); }
        } else {
            if (ui > 0 || true) {
#pragma unroll
                for (int a_ = 0; a_ < 2; ++a_)
#pragma unroll
                    for (int b_ = 0; b_ < 2; ++b_)
#pragma unroll
                        for (int m_ = 0; m_ < 4; ++m_)
#pragma unroll
                            for (int n_ = 0; n_ < 2; ++n_) acc[a_][b_][m_][n_] = (f32x4){0.f, 0.f, 0.f, 0.f};
            }
            for (int t = 0; t < nt; t += 2) { const bool last = (t == nt - 2); PG8_BODY(false); }
        }
        PG8_SCHED;
        { const int l2_ = fresh_lane(); E(acc, cur, wr, wc, l2_ & 15, l2_ >> 4, lds); }
        PG8_SCHED;
        if (!has_next) break;
        cur = nxt; cA = nA; cB = nB; ++ui;
    }
    PG8_WAIT_V(0);
    if (wr == 0) PG8_BAR;
    PG8_BAR;
#undef PG8_BODY
#undef PG8_SA
#undef PG8_SB
#undef PG8_STAGE
#undef PG8_LDA
#undef PG8_LDB
#undef PG8_MMA
#undef PG8_WAIT_V
#undef PG8_WAIT_L
#undef PG8_BAR
#undef PG8_SCHED
}

struct EpiSwiGLU {
    static constexpr bool PERM = true, IDEMPOTENT = true;
    bf16_t* O; const u32s* rowss;
    __device__ __forceinline__ void stage(LAS unsigned char* lds, const Unit& u, int wid, int lane) const {
        if (wid < 4) __builtin_amdgcn_global_load_lds((const unsigned*)(rowss + u.pm * BM + wid * 64 + lane), (LAS unsigned*)(lds + LDS_RS + wid * 256), 4, 0, 0);
    }
    __device__ __forceinline__ void operator()(const f32x4 (&acc)[2][2][4][2], const Unit& u, int wr, int wc, int fr, int fq, LAS unsigned char* lds) const {
        const int row0 = u.pm * BM + wr * 64 + fr, col0 = u.pn * HALF + wc * 32 + 8 * fq;
        u32s rs[2][4];
#pragma unroll
        for (int ai = 0; ai < 2; ++ai)
#pragma unroll
            for (int m = 0; m < 4; ++m) rs[ai][m] = ((const LAS u32s*)(lds + LDS_RS))[wr * 64 + ai * HALF + m * 16 + fr];
#pragma unroll
        for (int ai = 0; ai < 2; ++ai)
#pragma unroll
            for (int m = 0; m < 4; ++m) {
                const int row = row0 + ai * HALF + m * 16;
                const float kk = (float)rs[ai][m] * (SS_INV / D) + EPS;
                const float rstd = __builtin_amdgcn_rsqf(kk);
                u32x4 w; unsigned* wp = (unsigned*)&w;
                const float c1 = -1.4426950409f * rstd;
#pragma unroll
                for (int n = 0; n < 2; ++n) {
                    const f32x4 ag = acc[ai][0][m][n], au = acc[ai][1][m][n]; const f32x4 t = ag * c1, p = ag * au; f32x4 o;
#pragma unroll
                    for (int e = 0; e < 4; ++e) o[e] = p[e] * __builtin_amdgcn_rcpf(__builtin_fmaf(__builtin_amdgcn_exp2f(t[e]), kk, kk));
                    wp[2 * n] = cvt_pk_bf16(o[0], o[1]); wp[2 * n + 1] = cvt_pk_bf16(o[2], o[3]);
                }
                *(u32x4*)(O + ((((size_t)u.pm * (DFFP / BK) + (col0 >> 6)) * BM + (row & (BM - 1))) * BK + (col0 & (BK - 1)))) = w;
            }
    }
};
struct EpiResid {
    static constexpr bool PERM = true, IDEMPOTENT = false;
    bf16_t* xb; u32s* rowss_out; float alpha;
    __device__ __forceinline__ void stage(LAS unsigned char*, const Unit&, int, int) const {}
    __device__ __forceinline__ void operator()(const f32x4 (&acc)[2][2][4][2], const Unit& u, int wr, int wc, int fr, int fq, LAS unsigned char*) const {
        const int row0 = u.pm * BM + wr * 64 + fr, col0 = u.pn * BM + wc * 32 + 8 * fq;
        u32x4 ring[RESID_DEPTH][2];
#pragma unroll
        for (int g = 0; g < RESID_DEPTH; ++g) { const int rown = row0 + (g >> 2) * HALF + (g & 3) * 16;
#pragma unroll
            for (int bj = 0; bj < 2; ++bj) ring[g][bj] = *(const u32x4*)(xb + (size_t)rown * D + col0 + bj * HALF); }
#pragma unroll
        for (int g = 0; g < 8; ++g) {
            const int ai = g >> 2, m = g & 3;
            const int row = row0 + ai * HALF + m * 16; const size_t off = (size_t)row * D + col0; float ss = 0.f;
            u32x4 bw[2];
#pragma unroll
            for (int bj = 0; bj < 2; ++bj) bw[bj] = ring[g % RESID_DEPTH][bj];
            if (g + RESID_DEPTH < 8) { const int rown = row0 + ((g + RESID_DEPTH) >> 2) * HALF + ((g + RESID_DEPTH) & 3) * 16;
#pragma unroll
                for (int bj = 0; bj < 2; ++bj) ring[g % RESID_DEPTH][bj] = *(const u32x4*)(xb + (size_t)rown * D + col0 + bj * HALF); }
#pragma unroll
            for (int bj = 0; bj < 2; ++bj) {
                const f32x4 o0 = unpack4((u32x2){bw[bj].x, bw[bj].y}) + alpha * acc[ai][bj][m][0];
                const f32x4 o1 = unpack4((u32x2){bw[bj].z, bw[bj].w}) + alpha * acc[ai][bj][m][1];
                const u32x2 p0 = pack4(o0), p1 = pack4(o1);
                *(u32x4*)(xb + off + bj * HALF) = (u32x4){p0.x, p0.y, p1.x, p1.y};
                ss += ((o0[0] * o0[0] + o0[1] * o0[1]) + (o0[2] * o0[2] + o0[3] * o0[3])) + ((o1[0] * o1[0] + o1[1] * o1[1]) + (o1[2] * o1[2] + o1[3] * o1[3]));
            }
            { const int ln_ = fq * 16 + fr; ss += shfl_xor_l(ss, 16, ln_); ss += shfl_xor_l(ss, 32, ln_); }
            if (fq == 0) atomicAdd(rowss_out + row, (u32s)(ss * SS_SCALE));
        }
    }
};
struct EpiP {
    static constexpr bool PERM = true, IDEMPOTENT = false;
    bf16_t* O; const u32s* rowss;
    __device__ __forceinline__ void stage(LAS unsigned char* lds, const Unit& u, int wid, int lane) const {
        if (wid < 4) __builtin_amdgcn_global_load_lds((const unsigned*)(rowss + u.pm * BM + wid * 64 + lane), (LAS unsigned*)(lds + LDS_RS + wid * 256), 4, 0, 0);
    }
    __device__ __forceinline__ void operator()(const f32x4 (&acc)[2][2][4][2], const Unit& u, int wr, int wc, int fr, int fq, LAS unsigned char* lds) const {
        const int row0 = u.pm * BM + wr * 64 + fr, col0 = u.pn * BM + wc * 32 + 8 * fq;
        u32s rs[2][4];
#pragma unroll
        for (int ai = 0; ai < 2; ++ai)
#pragma unroll
            for (int m = 0; m < 4; ++m) rs[ai][m] = ((const LAS u32s*)(lds + LDS_RS))[wr * 64 + ai * HALF + m * 16 + fr];
#pragma unroll
        for (int ai = 0; ai < 2; ++ai)
#pragma unroll
            for (int m = 0; m < 4; ++m) {
                const int row = row0 + ai * HALF + m * 16;
                const float rstd = __builtin_amdgcn_rsqf((float)rs[ai][m] * (SS_INV / D) + EPS);
#pragma unroll
                for (int bj = 0; bj < 2; ++bj) {
                    const f32x4 v0 = acc[ai][bj][m][0] * rstd, v1 = acc[ai][bj][m][1] * rstd;
                    u32x4 w; w.x = cvt_pk_bf16(v0[0], v0[1]); w.y = cvt_pk_bf16(v0[2], v0[3]); w.z = cvt_pk_bf16(v1[0], v1[1]); w.w = cvt_pk_bf16(v1[2], v1[3]);
                    *(u32x4*)(O + (size_t)row * DIN + col0 + bj * HALF) = w;
                }
            }
    }
};
}

#define RLX_AGENT __ATOMIC_RELAXED, __HIP_MEMORY_SCOPE_AGENT
#define XB_TMO      128
#define XB_XCNT(j)  (256  + 64 * (j))
#define XB_XSUB(j)  (1280 + 64 * (j))
#define XB_XGEN(j)  (2304 + 64 * (j))
#define XB_TOP      3328
#define XB_TOPGEN   3392
#define XCD_BAR_WORDS 3456
#define XB_SPIN_CAP (1u << 18)

__device__ __forceinline__ unsigned xb_ld(unsigned* p)              { return __hip_atomic_load(p, __ATOMIC_RELAXED, __HIP_MEMORY_SCOPE_AGENT); }
__device__ __forceinline__ unsigned xb_add(unsigned* p, unsigned v) { return __hip_atomic_fetch_add(p, v, __ATOMIC_RELAXED, __HIP_MEMORY_SCOPE_AGENT); }
__device__ __forceinline__ unsigned xb_xcc_id() { return (unsigned)__builtin_amdgcn_s_getreg((3 << 11) | 20) & 0xFu; }
#define XB_SPIN(cond, bar) do { unsigned _sp = 0; while (cond) { __builtin_amdgcn_s_sleep(1); \
    if ((++_sp & 255u) == 0u) { if (xb_ld(&(bar)[XB_TMO])) break; if (_sp > XB_SPIN_CAP) { atomicAdd(&(bar)[XB_TMO], 1u); break; } } } } while (0)

struct XcdBarrier {
    unsigned* bar; unsigned x; int wave;
    volatile LAS unsigned* st;
};

__device__ __forceinline__ XcdBarrier xcd_barrier_post(unsigned* bar, volatile LAS unsigned* st, int wave_s) {
    XcdBarrier b; b.bar = bar; b.x = xb_xcc_id(); b.st = st; b.wave = wave_s;
    if (wave_s == 0 && fresh_lane() == 0) (void)xb_add(&bar[XB_XCNT(b.x)], 1u);
    return b;
}
__device__ __forceinline__ void xcd_barrier_complete(unsigned* bar, unsigned x, unsigned& nloc, unsigned& nx) {
    const unsigned G = gridDim.x * gridDim.y * gridDim.z;
    unsigned sum, cnt, mine, sp = 0u;
    for (;;) {
        sum = 0u; cnt = 0u; mine = 0u;
#pragma unroll
        for (unsigned j = 0; j < 16; ++j) { const unsigned c = xb_ld(&bar[XB_XCNT(j)]); sum += c; cnt += (c > 0u) ? 1u : 0u; mine = (j == x) ? c : mine; }
        if (sum == G) break;
        __builtin_amdgcn_s_sleep(1);
        if ((++sp & 255u) == 0u) { if (xb_ld(&bar[XB_TMO])) break; if (sp > XB_SPIN_CAP) { atomicAdd(&bar[XB_TMO], 1u); break; } }
    }
    nloc = mine > 0u ? mine : 1u; nx = cnt > 0u ? cnt : 1u;
}

__device__ __forceinline__ void xcd_barrier(const XcdBarrier& b) {
    asm volatile("s_waitcnt vmcnt(0)" ::: "memory");
    __syncthreads();
    if (b.wave == 0 && fresh_lane() == 0) {
        unsigned* bar = b.bar;
        __builtin_amdgcn_s_waitcnt(0);
        unsigned nloc = b.st[0], nx = b.st[1];
        if (nloc == 0u) { xcd_barrier_complete(bar, b.x, nloc, nx); b.st[0] = nloc; b.st[1] = nx; }
        const unsigned old = xb_add(&bar[XB_XSUB(b.x)], 1u);
        const unsigned gen = old / nloc;
        if (old + 1u == (gen + 1u) * nloc) {
            __builtin_amdgcn_fence(__ATOMIC_RELEASE, "agent");
            asm volatile("s_waitcnt vmcnt(0)" ::: "memory");
            const unsigned og = xb_add(&bar[XB_TOP], 1u);
            const unsigned tg = og / nx;
            if (og + 1u == (tg + 1u) * nx) xb_add(&bar[XB_TOPGEN], 1u);
            else XB_SPIN(xb_ld(&bar[XB_TOPGEN]) == tg, bar);
            __builtin_amdgcn_fence(__ATOMIC_ACQUIRE, "agent");
            xb_add(&bar[XB_XGEN(b.x)], 1u);
            asm volatile("s_waitcnt vmcnt(0)" ::: "memory");
        } else {
            XB_SPIN(xb_ld(&bar[XB_XGEN(b.x)]) == gen, bar);
            __builtin_amdgcn_fence(__ATOMIC_ACQUIRE, "agent");
            asm volatile("s_waitcnt vmcnt(0)" ::: "memory");
        }
    }
    __syncthreads();
}


struct Args { const float* in[23]; float* out; unsigned char* ws; };
enum { I_X = 0, I_F1N, I_F1WI, I_F1WO, I_MIXN, I_WIN, I_CONVW, I_CONVB, I_RGWA, I_RGBA, I_RGWX, I_RGBX, I_LAM, I_POOLW, I_POOLS, I_SGUN, I_SGUW, I_SGUB, I_WOUT, I_F2N, I_F2WI, I_F2WO, I_FINN };

__device__ __forceinline__ void transpose_block(const float* src, int lds_, const float* gain, bf16_t* dst, int ldd, int k0, int nd0, int sc0, bool valid, LAS float* scr, int lane) {
    const int c = lane & 7;
    if (!valid) {
#pragma unroll
        for (int j = 0; j < 4; ++j) { const int n = (lane >> 3) + 8 * j; *(u32x4*)(dst + (size_t)(nd0 + n) * ldd + k0 + 8 * c) = (u32x4){0u, 0u, 0u, 0u}; }
        return;
    }
#pragma unroll 16
    for (int i = 0; i < 32; ++i) { const int kk = 2 * i + (lane >> 5); float v = src[(size_t)(k0 + kk) * lds_ + sc0 + (lane & 31)]; if (gain) v *= gain[k0 + kk]; scr[kk * 33 + (lane & 31)] = v; }
    asm volatile("s_waitcnt lgkmcnt(0)" ::: "memory");
#pragma unroll
    for (int j = 0; j < 4; ++j) { const int n = (lane >> 3) + 8 * j; const LAS float* s = scr + (8 * c) * 33 + n;
        u32x4 o; o.x = cvt_pk_bf16(s[0 * 33], s[1 * 33]); o.y = cvt_pk_bf16(s[2 * 33], s[3 * 33]); o.z = cvt_pk_bf16(s[4 * 33], s[5 * 33]); o.w = cvt_pk_bf16(s[6 * 33], s[7 * 33]);
        *(u32x4*)(dst + (size_t)(nd0 + n) * ldd + k0 + 8 * c) = o; }
    asm volatile("s_waitcnt lgkmcnt(0)" ::: "memory");
}

__device__ __forceinline__ void prologue(const Args& a, LAS unsigned char* lds, int wave_s) {
    const int tid_ = fresh_tid(wave_s);
    const int tid = tid_, lane = tid & 63, wave = tid >> 6;
    const int gw = blockIdx.x * 8 + wave, NGW = gridDim.x * 8;
    unsigned char* ws = a.ws;
    LAS float* scr = (LAS float*)(lds + wave * 16384);
    constexpr int IT_FIN = (D / 64) * (NFF / 32), IT_FOUT = (DFFP / 64) * (D / 32), IT_WIN = (D / 64) * (DIN / 32), IT_WOUT = (D / 64) * (D / 32);
    constexpr int IT_L = 2 * IT_FIN + 2 * IT_FOUT + IT_WIN + IT_WOUT;
    for (int it = gw; it < DEPTH * IT_L; it += NGW) {
        const int l = it / IT_L; int r = it % IT_L;
        unsigned char* wl = ws + (size_t)l * WS_WL;
        if (r < 2 * IT_FIN) {
            const int f = r / IT_FIN; r %= IT_FIN; const int kb = r / (NFF / 32), nb = r % (NFF / 32);
            const int nd0 = nb * 32, pn = nd0 >> 8, bj = (nd0 >> 7) & 1, f0 = pn * 128 + (nd0 & 127);
            const float* src = a.in[f ? I_F2WI : I_F1WI] + (size_t)l * D * 2 * DFF; const float* gain = a.in[f ? I_F2N : I_F1N] + l * D;
            transpose_block(src, 2 * DFF, gain, (bf16_t*)(wl + (f ? WO_FFNIN1 : WO_FFNIN0)), D, kb * 64, nd0, bj * DFF + f0, f0 < DFF, scr, lane);
            continue;
        }
        r -= 2 * IT_FIN;
        if (r < 2 * IT_FOUT) {
            const int f = r / IT_FOUT; r %= IT_FOUT; const int kb = r / (D / 32), nb = r % (D / 32);
            const float* src = a.in[f ? I_F2WO : I_F1WO] + (size_t)l * DFF * D;
            transpose_block(src, D, nullptr, (bf16_t*)(wl + (f ? WO_FFNOUT1 : WO_FFNOUT0)), DFFP, kb * 64, nb * 32, nb * 32, kb * 64 < DFF, scr, lane);
            continue;
        }
        r -= 2 * IT_FOUT;
        if (r < IT_WIN) {
            const int kb = r / (DIN / 32), nb = r % (DIN / 32);
            transpose_block(a.in[I_WIN] + (size_t)l * D * DIN, DIN, a.in[I_MIXN] + l * D, (bf16_t*)(wl + WO_WIN), D, kb * 64, nb * 32, nb * 32, true, scr, lane);
            continue;
        }
        r -= IT_WIN;
        { const int kb = r / (D / 32), nb = r % (D / 32);
          transpose_block(a.in[I_WOUT] + (size_t)l * D * D, D, nullptr, (bf16_t*)(wl + WO_WOUT), D, kb * 64, nb * 32, nb * 32, true, scr, lane); }
    }
    const int gt = blockIdx.x * NTHREADS + tid, NGT = gridDim.x * NTHREADS;
    for (int i = gt; i < DEPTH * 8 * 64 * 64; i += NGT) {
        const int l = i >> 15, rem = i & 32767, h = rem >> 12, n = (rem >> 6) & 63, k = rem & 63;
        const size_t s = ((size_t)(l * 8 + h) * 64 + k) * 64 + n;
        bf16_t* sm = (bf16_t*)(ws + WS_SMALL + (size_t)l * SMALL_L);
        sm[SO_RGA / 2 + rem] = (bf16_t)(cvt_pk_bf16(a.in[I_RGWA][s] * -1.4426950409f, 0.f) & 0xffffu);
        sm[SO_RGX / 2 + rem] = (bf16_t)(cvt_pk_bf16(a.in[I_RGWX][s] * -1.4426950409f, 0.f) & 0xffffu);
    }
    for (int i = gt; i < DEPTH * 4 * 64 * 64; i += NGT) {
        const int l = i >> 14, rem = i & 16383, g = rem >> 12, n = (rem >> 6) & 63, k = rem & 63;
        const size_t s = ((size_t)(l * 4 + g) * 64 + k) * 64 + n;
        bf16_t* sm = (bf16_t*)(ws + WS_SMALL + (size_t)l * SMALL_L);
        sm[SO_POOL / 2 + rem] = (bf16_t)(cvt_pk_bf16(a.in[I_POOLW][s], 0.f) & 0xffffu);
    }
    for (int i = gt; i < DEPTH * 4 * 128 * 128; i += NGT) {
        const int l = i >> 16, rem = i & 65535, t = (rem >> 7) & 127, s = rem & 127;
        bf16_t* sm = (bf16_t*)(ws + WS_SMALL + (size_t)l * SMALL_L);
        const float v = (s <= t) ? a.in[I_SGUW][i] : 0.f;
        sm[SO_SGU / 2 + rem] = (bf16_t)(cvt_pk_bf16(v, 0.f) & 0xffffu);
    }
    u32s* rowss = (u32s*)(ws + WS_ROWSS);
    for (int i = gt; i < 6 * M; i += NGT) rowss[M + i] = 0u;
    bf16_t* XB = (bf16_t*)(ws + WS_XB);
    for (int m0 = gw * 4; m0 < M; m0 += NGW * 4) {
        f32x4 v[4][4];
#pragma unroll
        for (int i = 0; i < 4; ++i)
#pragma unroll
            for (int j = 0; j < 4; ++j) v[i][j] = ((const f32x4*)(a.in[I_X] + (size_t)(m0 + i) * D) + lane)[64 * j];
#pragma unroll
        for (int i = 0; i < 4; ++i) {
            u32x2* o8 = (u32x2*)(XB + (size_t)(m0 + i) * D) + lane; float ss = 0.f;
#pragma unroll
            for (int j = 0; j < 4; ++j) { const f32x4 w = v[i][j]; ss += (w.x * w.x + w.y * w.y) + (w.z * w.z + w.w * w.w); o8[64 * j] = pack4(w); }
#pragma unroll
            for (int o = 1; o < 64; o <<= 1) ss += shfl_xor_l(ss, o, lane);
            if (lane == 0) rowss[m0 + i] = (u32s)(ss * SS_SCALE);
        }
    }
}

__device__ __forceinline__ void load_rglru_consts(const Args& a, int l, LAS float* cst, int wave_s) {
    const int ch = fresh_tid(wave_s);
#pragma unroll
    for (int k = 0; k < 4; ++k) cst[k * 512 + ch] = a.in[I_CONVW][(l * 4 + k) * 512 + ch];
    cst[4 * 512 + ch] = a.in[I_CONVB][l * 512 + ch];
    cst[5 * 512 + ch] = a.in[I_RGBA][l * 512 + ch] * -1.4426950409f;
    cst[6 * 512 + ch] = a.in[I_RGBX][l * 512 + ch] * -1.4426950409f;
    cst[7 * 512 + ch] = -1.0f / (8.0f * log1pf(expf(-a.in[I_LAM][l * 512 + ch])) * 1.4426950409f);
    __syncthreads();
}

template <bool FINAL>
__device__ __forceinline__ void rglru_phase(const Args& a, int l, LAS unsigned char* lds, int wave_s) {
    const int tid_ = fresh_tid(wave_s);
    const int tid = tid_, lane = tid & 63, h = tid >> 6, r = lane & 15, q = lane >> 4;
    unsigned char* ws = a.ws;
    const bf16_t* P = (const bf16_t*)(ws + WS_P); bf16_t* Y = (bf16_t*)(ws + WS_Y);
    float* sumA = (float*)(ws + WS_SUMA); float* sumH = (float*)(ws + WS_SUMH);
    LAS float* cst = (LAS float*)lds;
    const int chl = 64 * h + 4 * q;
    const bf16_t* sm = (const bf16_t*)(ws + WS_SMALL + (size_t)l * SMALL_L);
    bf16x8 WaF[4][2], WxF[4][2];
#pragma unroll
    for (int nt = 0; nt < 4; ++nt)
#pragma unroll
        for (int ks = 0; ks < 2; ++ks) {
            const size_t o = ((size_t)h * 64 + 16 * nt + r) * 64 + 32 * ks + 4 * q;
            WaF[nt][ks] = mk8(*(const u32x2*)(sm + SO_RGA / 2 + o), *(const u32x2*)(sm + SO_RGA / 2 + o + 16));
            WxF[nt][ks] = mk8(*(const u32x2*)(sm + SO_RGX / 2 + o), *(const u32x2*)(sm + SO_RGX / 2 + o + 16));
        }
    for (int it = blockIdx.x; it < BATCH * NCH; it += gridDim.x) {
        const int b = it / NCH, c = it % NCH;
        f32x4 cH[4], cA[4];
#pragma unroll
        for (int nt = 0; nt < 4; ++nt) { cH[nt] = (f32x4){0.f, 0.f, 0.f, 0.f}; cA[nt] = (f32x4){1.f, 1.f, 1.f, 1.f}; }
        if (FINAL) {
            f32x4 H1[4];
#pragma unroll
            for (int grp = 0; grp < 2; ++grp) {
                const int cp = r + 16 * grp; const bool valid = cp < c;
                const size_t so = ((size_t)(b * NCH + (valid ? cp : 0))) * 512 + chl;
#pragma unroll
                for (int nt = 0; nt < 4; ++nt) {
                    f32x4 A = *(const f32x4*)(sumA + so + 16 * nt), H = *(const f32x4*)(sumH + so + 16 * nt);
                    if (!valid) { A = (f32x4){1.f, 1.f, 1.f, 1.f}; H = (f32x4){0.f, 0.f, 0.f, 0.f}; }
#define SCAN_STEP(SH) { float T_ = 1.0f;   _Pragma("unroll") for (int j = 0; j < 4; ++j) { const float Hp = dpp_shr0<SH>(H[j]); T_ = dpp_shr<SH>(T_, A[j]); H[j] = A[j] * Hp + H[j]; A[j] = A[j] * T_; } }
                    SCAN_STEP(1) SCAN_STEP(2) SCAN_STEP(4) SCAN_STEP(8)
#undef SCAN_STEP
                    if (grp == 0) H1[nt] = H; else cH[nt] = A * H1[nt] + H;
                }
            }
        }
        u32x2 nx[4][4];
#define RG_ISSUE(MT) do { const int pos_ = c * TCH + 16 * (MT) + r; const size_t tok_ = (size_t)b * SEQ + pos_; \
            _Pragma("unroll") for (int k = 0; k < 4; ++k) { _Pragma("unroll") for (int nt = 0; nt < 4; ++nt) nx[k][nt] = (u32x2){0u, 0u}; \
                if (pos_ - 3 + k >= 0) { _Pragma("unroll") for (int nt = 0; nt < 4; ++nt) nx[k][nt] = *(const u32x2*)(P + (tok_ - 3 + k) * DIN + 512 + chl + 16 * nt); } } \
            } while (0)
        RG_ISSUE(0);
#pragma unroll 1
        for (int mt = 0; mt < TCH / 16; ++mt) {
            asm volatile("" ::: "memory");
            const int pos = c * TCH + 16 * mt + r; const size_t tok = (size_t)b * SEQ + pos;
            f32x4 xc[4]; u32x2 gcur[4];
#pragma unroll
            for (int nt = 0; nt < 4; ++nt) { xc[nt] = *(const LAS f32x4*)(cst + 4 * 512 + chl + 16 * nt); if (FINAL) gcur[nt] = *(const u32x2*)(P + tok * DIN + chl + 16 * nt); }
#pragma unroll
            for (int k = 0; k < 4; ++k)
#pragma unroll
                for (int nt = 0; nt < 4; ++nt) xc[nt] += *(const LAS f32x4*)(cst + k * 512 + chl + 16 * nt) * unpack4(nx[k][nt]);
            __builtin_amdgcn_sched_barrier(0);
            if (mt + 1 < TCH / 16) RG_ISSUE(mt + 1);
            __builtin_amdgcn_sched_barrier(0);
            bf16x8 Xf[2];
#pragma unroll
            for (int ks = 0; ks < 2; ++ks) Xf[ks] = mk8(pack4(xc[2 * ks]), pack4(xc[2 * ks + 1]));
#pragma unroll
            for (int nt = 0; nt < 4; ++nt) {
                const f32x4 sp = *(const LAS f32x4*)(cst + 7 * 512 + chl + 16 * nt);
                f32x4 ar = *(const LAS f32x4*)(cst + 5 * 512 + chl + 16 * nt), ai = *(const LAS f32x4*)(cst + 6 * 512 + chl + 16 * nt);
#pragma unroll
                for (int ks = 0; ks < 2; ++ks) { ar = __builtin_amdgcn_mfma_f32_16x16x32_bf16(WaF[nt][ks], Xf[ks], ar, 0, 0, 0); ai = __builtin_amdgcn_mfma_f32_16x16x32_bf16(WxF[nt][ks], Xf[ks], ai, 0, 0, 0); }
                f32x4 A, H;
#pragma unroll
                for (int j = 0; j < 4; ++j) {
                    const float ii = __builtin_amdgcn_rcpf(1.0f + __builtin_amdgcn_exp2f(ai[j]));
                    const float av = __builtin_amdgcn_exp2f(__builtin_amdgcn_rcpf(__builtin_fmaf(__builtin_amdgcn_exp2f(ar[j]), sp[j], sp[j])));
                    const float mult = __builtin_amdgcn_sqrtf(1.0f - av * av);
                    A[j] = av; H[j] = mult * (ii * xc[nt][j]);
                }
#pragma unroll
                for (int j = 0; j < 4; ++j) {
                    const float hin = (!FINAL && mt == 0) ? cH[nt][j] : dpp_ror1(cH[nt][j]);
                    const float Hn = A[j] * hin + H[j];
                    H[j] = (r == 0) ? Hn : H[j];
                    if (!FINAL) { const float ain = (mt == 0) ? cA[nt][j] : dpp_ror1(cA[nt][j]); const float An = A[j] * ain; A[j] = (r == 0) ? An : A[j]; }
                }
#define SCAN_STEP(SH) { float T_ = 1.0f;   _Pragma("unroll") for (int j = 0; j < 4; ++j) { const float Hp = dpp_shr0<SH>(H[j]); T_ = dpp_shr<SH>(T_, A[j]); H[j] = A[j] * Hp + H[j]; A[j] = A[j] * T_; } }
                SCAN_STEP(1) SCAN_STEP(2) SCAN_STEP(4) SCAN_STEP(8)
#undef SCAN_STEP
                cH[nt] = H;
                __builtin_amdgcn_sched_barrier(0);
                if (FINAL) {
                    const f32x4 g = gelu4(unpack4(gcur[nt]));
                    *(u32x2*)(Y + tok * D + chl + 16 * nt) = pack4(g * H);
                } else {
                    cA[nt] = A;
                }
            }
        }
#undef RG_ISSUE
        if (!FINAL && r == 15) {
            const size_t so = ((size_t)(b * NCH + c)) * 512 + chl;
#pragma unroll
            for (int nt = 0; nt < 4; ++nt) { *(f32x4*)(sumA + so + 16 * nt) = cA[nt]; *(f32x4*)(sumH + so + 16 * nt) = cH[nt]; }
        }
    }
}

__device__ __forceinline__ void pool_phase(const Args& a, int l, int wave_s) {
    const int tid_ = fresh_tid(wave_s);
    const int tid = tid_, lane = tid & 63, wave = tid >> 6, r = lane & 15, q = lane >> 4, g = wave & 3, half = wave >> 2;
    unsigned char* ws = a.ws;
    const bf16_t* P = (const bf16_t*)(ws + WS_P); bf16_t* Y = (bf16_t*)(ws + WS_Y);
    const bf16_t* sm = (const bf16_t*)(ws + WS_SMALL + (size_t)l * SMALL_L) + SO_POOL / 2;
    const int chl = 64 * g + 4 * q, win = 2 << g;
    bf16x8 PF[4][2]; f32x4 sc[4];
#pragma unroll
    for (int nt = 0; nt < 4; ++nt) {
        sc[nt] = *(const f32x4*)(a.in[I_POOLS] + l * DPOOL + chl + 16 * nt);
#pragma unroll
        for (int ks = 0; ks < 2; ++ks) { const size_t o = ((size_t)g * 64 + 16 * nt + r) * 64 + 32 * ks + 4 * q; PF[nt][ks] = mk8(*(const u32x2*)(sm + o), *(const u32x2*)(sm + o + 16)); }
    }
    for (int it = blockIdx.x; it < M / 128; it += gridDim.x) {
        const int b = it / (SEQ / 128), pos0 = (it % (SEQ / 128)) * 128 + half * 64;
#pragma unroll 1
        for (int mt = 0; mt < 4; ++mt) {
            const int pos = pos0 + 16 * mt + r; const size_t tok = (size_t)b * SEQ + pos;
            f32x4 sum[4], x0[4], sp[4];
#pragma unroll
            for (int nt = 0; nt < 4; ++nt) { x0[nt] = unpack4(*(const u32x2*)(P + tok * DIN + 1024 + chl + 16 * nt)); sum[nt] = x0[nt]; sp[nt] = (f32x4){0.f, 0.f, 0.f, 0.f}; }
            if (pos0 + 16 * mt >= 16) {
#pragma unroll
                for (int nt = 0; nt < 4; ++nt) sp[nt] = unpack4(*(const u32x2*)(P + (tok - 16) * DIN + 1024 + chl + 16 * nt));
            }
#define POOL_STEP(K) if (win > (K)) { _Pragma("unroll") for (int nt = 0; nt < 4; ++nt) _Pragma("unroll") for (int j = 0; j < 4; ++j) { \
                const float tc = dpp_ror<K>(sum[nt][j]), tp = dpp_ror<K>(sp[nt][j]); sum[nt][j] += (r >= (K)) ? tc : tp; sp[nt][j] += tp; } }
            POOL_STEP(1) POOL_STEP(2) POOL_STEP(4) POOL_STEP(8)
#undef POOL_STEP
            const float inv = 1.0f / (float)((pos + 1 < win) ? pos + 1 : win);
            f32x4 d[4];
#pragma unroll
            for (int nt = 0; nt < 4; ++nt) d[nt] = sum[nt] * inv - x0[nt];
            bf16x8 Xf[2];
#pragma unroll
            for (int ks = 0; ks < 2; ++ks) Xf[ks] = mk8(pack4(d[2 * ks]), pack4(d[2 * ks + 1]));
#pragma unroll
            for (int nt = 0; nt < 4; ++nt) {
                f32x4 acc = (f32x4){0.f, 0.f, 0.f, 0.f};
                acc = __builtin_amdgcn_mfma_f32_16x16x32_bf16(PF[nt][0], Xf[0], acc, 0, 0, 0);
                acc = __builtin_amdgcn_mfma_f32_16x16x32_bf16(PF[nt][1], Xf[1], acc, 0, 0, 0);
                *(u32x2*)(Y + tok * D + 512 + chl + 16 * nt) = pack4(acc * sc[nt]);
            }
        }
    }
}

constexpr int VP = 136;
__device__ __forceinline__ void sgu_phase(const Args& a, int l, LAS unsigned char* lds, int wave_s) {
    const int tid_ = fresh_tid(wave_s);
    const int tid = tid_, lane = tid & 63, wave = tid >> 6, r = lane & 15, q = lane >> 4;
    unsigned char* ws = a.ws;
    const bf16_t* P = (const bf16_t*)(ws + WS_P); bf16_t* Y = (bf16_t*)(ws + WS_Y);
    const bf16_t* sw = (const bf16_t*)(ws + WS_SMALL + (size_t)l * SMALL_L) + SO_SGU / 2;
    LAS bf16_t* Vt = (LAS bf16_t*)(lds + 16384);
    for (int it = blockIdx.x; it < M / 128; it += gridDim.x) {
        const size_t tok0 = (size_t)it * 128;
        {
            const size_t tok = tok0 + 16 * wave + r;
            f32x4 v[16]; float ss = 0.f;
#pragma unroll
            for (int i = 0; i < 16; ++i) { v[i] = gelu4(unpack4(*(const u32x2*)(P + tok * DIN + 1536 + 16 * i + 4 * q))); ss += (v[i].x * v[i].x + v[i].y * v[i].y) + (v[i].z * v[i].z + v[i].w * v[i].w); }
            ss += shfl_xor_l(ss, 16, lane); ss += shfl_xor_l(ss, 32, lane);
            const float rstd = __builtin_amdgcn_rsqf(ss * (1.0f / DSGU) + EPS);
#pragma unroll
            for (int i = 0; i < 16; ++i) {
                const f32x4 gn = *(const f32x4*)(a.in[I_SGUN] + l * DSGU + 16 * i + 4 * q);
                const f32x4 o = v[i] * gn * rstd;
                const u32x2 w = pack4(o);
                LAS bf16_t* dst = Vt + (16 * i + 4 * q) * VP + 16 * wave + r;
                dst[0] = (bf16_t)(w.x & 0xffffu); dst[VP] = (bf16_t)(w.x >> 16); dst[2 * VP] = (bf16_t)(w.y & 0xffffu); dst[3 * VP] = (bf16_t)(w.y >> 16);
            }
        }
        __syncthreads();
        {
            const int hh = wave & 3, grp = wave >> 2;
#pragma unroll 1
            for (int mi = 0; mi < 4; ++mi) {
                const int aa = 2 * grp + (mi >> 1), mt = (mi & 1) ? 7 - aa : aa, nks = (mt >> 1) + 1;
                f32x4 acc[4];
#pragma unroll
                for (int nt = 0; nt < 4; ++nt) acc[nt] = (f32x4){0.f, 0.f, 0.f, 0.f};
                const bf16_t* Wrow = sw + ((size_t)hh * 128 + 16 * mt + r) * 128 + 8 * q;
                const size_t tok = tok0 + 16 * mt + r;
                bf16x8 Wf[4]; u32x2 uw[4];
#pragma unroll
                for (int ks = 0; ks < 4; ++ks) Wf[ks] = *(const bf16x8*)(Wrow + 32 * (ks < nks ? ks : 0));
#pragma unroll
                for (int nt = 0; nt < 4; ++nt) uw[nt] = *(const u32x2*)(P + tok * DIN + 1280 + 64 * hh + 16 * nt + 4 * q);
                const float bias = a.in[I_SGUB][(l * 4 + hh) * 128 + 16 * mt + r];
#pragma unroll
                for (int ks = 0; ks < 4; ++ks) {
                    if (ks < nks) {
#pragma unroll
                        for (int nt = 0; nt < 4; ++nt) {
                            const bf16x8 Vf = *(const LAS bf16x8*)(Vt + (64 * hh + 16 * nt + r) * VP + 32 * ks + 8 * q);
                            acc[nt] = __builtin_amdgcn_mfma_f32_16x16x32_bf16(Vf, Wf[ks], acc[nt], 0, 0, 0);
                        }
                    }
                }
#pragma unroll
                for (int nt = 0; nt < 4; ++nt) {
                    const f32x4 uu = gelu4(unpack4(uw[nt]));
                    *(u32x2*)(Y + tok * D + 768 + 64 * hh + 16 * nt + 4 * q) = pack4(uu * (acc[nt] + bias));
                }
            }
        }
        __syncthreads();
    }
}

__device__ __forceinline__ void final_norm(const Args& a, int wave_s) {
    const int tid_ = fresh_tid(wave_s);
    const int tid = tid_, lane = tid & 63, wave = tid >> 6;
    const int gw = blockIdx.x * 8 + wave, NGW = gridDim.x * 8;
    const u32s* rowss = (const u32s*)(a.ws + WS_ROWSS) + (size_t)6 * M;
    f32x4 fn[4];
#pragma unroll
    for (int j = 0; j < 4; ++j) fn[j] = *((const f32x4*)a.in[I_FINN] + lane + 64 * j);
    const bf16_t* XB = (const bf16_t*)(a.ws + WS_XB);
    for (int m0 = gw * 4; m0 < M; m0 += NGW * 4) {
        u32x2 xi[4][4]; float rstd[4];
#pragma unroll
        for (int i = 0; i < 4; ++i) {
            rstd[i] = __builtin_amdgcn_rsqf((float)rowss[m0 + i] * (SS_INV / D) + EPS);
#pragma unroll
            for (int j = 0; j < 4; ++j) xi[i][j] = ((const u32x2*)(XB + (size_t)(m0 + i) * D) + lane)[64 * j];
        }
#pragma unroll
        for (int i = 0; i < 4; ++i) {
            f32x4* o = (f32x4*)(a.out + (size_t)(m0 + i) * D) + lane;
#pragma unroll
            for (int j = 0; j < 4; ++j) o[64 * j] = unpack4(xi[i][j]) * rstd[i] * fn[j];
        }
    }
}

#ifdef DBL_SYNC
#define GSYNC() do { xcd_barrier(xbar); xcd_barrier(xbar); } while (0)
#else
#define GSYNC() xcd_barrier(xbar)
#endif
#ifndef PEEL_G1
#define PEEL_G1 true
#endif
#ifndef PEEL_G2
#define PEEL_G2 true
#endif
#ifndef PEEL_G3
#define PEEL_G3 true
#endif
#ifndef PEEL_G4
#define PEEL_G4 true
#endif
__global__ void __launch_bounds__(NTHREADS, 2) mega_fwd(Args a) {
    extern __shared__ __attribute__((aligned(16))) unsigned char lds_raw[];
    LAS unsigned char* lds = (LAS unsigned char*)lds_raw;
    cg::grid_group grid = cg::this_grid();
    unsigned char* ws = a.ws;
    bf16_t* XB = (bf16_t*)(ws + WS_XB); bf16_t* ACT = (bf16_t*)(ws + WS_ACT); bf16_t* PB = (bf16_t*)(ws + WS_P); bf16_t* YB = (bf16_t*)(ws + WS_Y);
    u32s* rowss = (u32s*)(ws + WS_ROWSS);
    const int G = gridDim.x, bid = blockIdx.x;

    const int wave_s = __builtin_amdgcn_readfirstlane((int)(threadIdx.x >> 6));
    { volatile LAS unsigned* st = (volatile LAS unsigned*)(lds + 131072); if (threadIdx.x < 16) st[threadIdx.x] = 0u; }
    __syncthreads();
    const XcdBarrier xbar = xcd_barrier_post((unsigned*)(ws + WS_CTL), (volatile LAS unsigned*)(lds + 131072), wave_s);
    prologue(a, lds, wave_s);
#ifdef DBL_PRO
    prologue(a, lds, wave_s);
#endif
    if (a.ws == nullptr) grid.sync();
    xcd_barrier(xbar);

    int nrm = 0;
#pragma unroll 1
    for (int l = 0; l < DEPTH; ++l) {
        const unsigned char* wl = ws + (size_t)l * WS_WL;
#pragma unroll 1
        for (int f = 0; f < 2; ++f) {
            {
                pg8::Gemm g{XB, (const bf16_t*)(wl + (f ? WO_FFNIN1 : WO_FFNIN0)), M, NFF, D}; pg8::StaticOrder S; S.init(M, NFF, G, bid);
                pg8::EpiSwiGLU E{ACT, rowss + (size_t)nrm * M};
                pg8::gemm_phase<pg8::EpiSwiGLU, false, PEEL_G1, NFF / 256>(lds, g, S, E, wave_s);
#ifdef DBL_G1
                pg8::gemm_phase(lds, g, S, E, wave_s);
#endif
            }
            GSYNC();
            {
                pg8::Gemm g{ACT, (const bf16_t*)(wl + (f ? WO_FFNOUT1 : WO_FFNOUT0)), M, D, DFFP}; pg8::StaticOrder S; S.init(M, D, G, bid);
                pg8::EpiResid E{XB, rowss + (size_t)(nrm + 1) * M, 0.5f};
                pg8::gemm_phase<pg8::EpiResid, true, PEEL_G2, D / 256>(lds, g, S, E, wave_s);
            }
            ++nrm;
            GSYNC();
            if (f == 0) {
                {
                    pg8::Gemm g{XB, (const bf16_t*)(wl + WO_WIN), M, DIN, D}; pg8::StaticOrder S; S.init(M, DIN, G, bid);
                    pg8::EpiP E{PB, rowss + (size_t)nrm * M};
                    pg8::gemm_phase<pg8::EpiP, false, PEEL_G3, DIN / 256>(lds, g, S, E, wave_s);
#ifdef DBL_G3
                    pg8::gemm_phase(lds, g, S, E, wave_s);
#endif
                }
                GSYNC();
                load_rglru_consts(a, l, (LAS float*)lds, wave_s);
                rglru_phase<false>(a, l, lds, wave_s);
#ifdef DBL_M1A
                rglru_phase<false>(a, l, lds, wave_s);
#endif
                pool_phase(a, l, wave_s);
#ifdef DBL_POOL
                pool_phase(a, l, wave_s);
#endif
                sgu_phase(a, l, lds, wave_s);
#ifdef DBL_SGU
                sgu_phase(a, l, lds, wave_s);
#endif
                GSYNC();
                rglru_phase<true>(a, l, lds, wave_s);
#ifdef DBL_M2
                rglru_phase<true>(a, l, lds, wave_s);
#endif
                GSYNC();
                {
                    pg8::Gemm g{YB, (const bf16_t*)(wl + WO_WOUT), M, D, D}; pg8::StaticOrder S; S.init(M, D, G, bid);
                    pg8::EpiResid E{XB, rowss + (size_t)(nrm + 1) * M, 1.0f};
                    pg8::gemm_phase<pg8::EpiResid, false, PEEL_G4, D / 256>(lds, g, S, E, wave_s);
                }
                ++nrm;
                GSYNC();
            }
        }
    }
    final_norm(a, wave_s);
}

extern "C" void kernel_launch(void* const* d_in, const int* in_sizes, int n_in, void* d_out, int out_size, void* d_ws, size_t ws_size, hipStream_t stream) {
    static int grid = 0;
    if (grid == 0) {
        if (n_in != 23 || in_sizes[0] != M * D || out_size != M * D || ws_size < WS_END) { fprintf(stderr, "kernel_launch: unexpected shapes (n_in %d, in0 %d, out %d, ws %zu)\n", n_in, n_in > 0 ? in_sizes[0] : -1, out_size, ws_size); grid = -1; return; }
        int dev = 0, cus = 0, per_cu = 0;
        hipGetDevice(&dev); hipDeviceGetAttribute(&cus, hipDeviceAttributeMultiprocessorCount, dev);
        if (hipFuncSetAttribute((const void*)mega_fwd, hipFuncAttributeMaxDynamicSharedMemorySize, LDS_BYTES) != hipSuccess) { fprintf(stderr, "kernel_launch: hipFuncSetAttribute failed\n"); }
        if (hipOccupancyMaxActiveBlocksPerMultiprocessor(&per_cu, (const void*)mega_fwd, NTHREADS, LDS_BYTES) != hipSuccess || per_cu < 1) { fprintf(stderr, "kernel_launch: occupancy query says %d\n", per_cu); per_cu = 1; }
        (void)hipGetLastError();
        grid = cus * 1;
        if (grid <= 0) grid = 256;
    }
    if (grid < 0) return;
    Args a{};
    for (int i = 0; i < 23; ++i) a.in[i] = (const float*)d_in[i];
    a.out = (float*)d_out; a.ws = (unsigned char*)d_ws;
    if (hipMemsetAsync((char*)d_ws + WS_CTL, 0, CTL_BYTES, stream) != hipSuccess) { fprintf(stderr, "kernel_launch: memset failed\n"); return; }
    void* args[] = {&a};
    hipError_t e = hipLaunchCooperativeKernel((const void*)mega_fwd, dim3(grid), dim3(NTHREADS), args, LDS_BYTES, stream);
    if (e != hipSuccess) fprintf(stderr, "kernel_launch: cooperative launch failed: %s (grid %d)\n", hipGetErrorString(e), grid);
}
```
